# Optimizing an MI355X kernel written in HIP

```python
import jax, jax.numpy as jnp
from jax import lax
import numpy as np

D_MODEL = 4096
BATCH = 1
SEQ = 8192
DEPTH = 1

HEAD_DIM = 128
FOX_HEADS = D_MODEL // (2 * HEAD_DIM)
DSA_HEADS = D_MODEL // (2 * HEAD_DIM)
FOX_WIDTH = FOX_HEADS * HEAD_DIM
DSA_WIDTH = DSA_HEADS * HEAD_DIM
MIX_WIDTH = FOX_WIDTH + DSA_WIDTH
IDX_HEADS = 16
IDX_DIM = 64
DSA_TOPK_MAX = 256
Q_BLOCK = 128
ROPE_THETA = 10000.0
NORM_EPS = 1e-6
PEER_HEADS = 8
PEER_NKEYS = 128
PEER_EXPERTS = PEER_NKEYS * PEER_NKEYS
PEER_QDIM = 128
PEER_SUBDIM = PEER_QDIM // 2
PEER_TOPK = 16
PEER_TOK_BLOCK = 64

IN_SIZES = (FOX_WIDTH, FOX_WIDTH, FOX_WIDTH, FOX_HEADS,
            DSA_WIDTH, HEAD_DIM, HEAD_DIM,
            IDX_HEADS * IDX_DIM, IDX_DIM, IDX_HEADS)
IN_WIDTH = FOX_WIDTH * 3 + FOX_HEADS + DSA_WIDTH + 2 * HEAD_DIM + IDX_HEADS * IDX_DIM + IDX_DIM + IDX_HEADS

kernel_name = "hymba_fox_dsa_peer_block"


def _split_points(sizes):
    pts, acc = [], 0
    for s in sizes[:-1]:
        acc += s
        pts.append(acc)
    return pts


def rmsnorm(x, g):
    xf = x.astype(jnp.float32)
    y = xf * lax.rsqrt(jnp.mean(xf * xf, axis=-1, keepdims=True) + NORM_EPS)
    return (y * g.astype(jnp.float32)).astype(x.dtype)


def rope(x, positions):
    d = x.shape[-1]
    inv = ROPE_THETA ** (-jnp.arange(0, d, 2, dtype=jnp.float32) / d)
    ang = positions.astype(jnp.float32)[..., None] * inv
    cos = jnp.cos(ang)[:, :, None, :]
    sin = jnp.sin(ang)[:, :, None, :]
    xf = x.astype(jnp.float32)
    x1, x2 = xf[..., : d // 2], xf[..., d // 2:]
    return jnp.concatenate([x1 * cos - x2 * sin, x2 * cos + x1 * sin], axis=-1).astype(x.dtype)


def fox_attention(q, k, v, log_f):
    B, S, H, hd = q.shape
    c = jnp.cumsum(log_f, axis=1).transpose(0, 2, 1)
    scale = hd ** -0.5
    kpos = jnp.arange(S)

    def block(i):
        start = i * Q_BLOCK
        qb = lax.dynamic_slice_in_dim(q, start, Q_BLOCK, axis=1)
        cb = lax.dynamic_slice_in_dim(c, start, Q_BLOCK, axis=2)
        s = jnp.einsum('bthd,bshd->bhts', qb, k, preferred_element_type=jnp.float32) * scale
        s = s + cb[..., None] - c[:, :, None, :]
        qpos = start + jnp.arange(Q_BLOCK)
        s = jnp.where(kpos[None, :] <= qpos[:, None], s, -jnp.inf)
        p = jax.nn.softmax(s, axis=-1).astype(v.dtype)
        return jnp.einsum('bhts,bshd->bthd', p, v)

    out = lax.map(block, jnp.arange(S // Q_BLOCK))
    return out.transpose(1, 0, 2, 3, 4).reshape(B, S, H, hd)


def dsa_attention(q, k, v, q_idx, k_idx, w_idx, topk):
    B, S, H, hd = q.shape
    scale = hd ** -0.5
    idx_scale = IDX_DIM ** -0.5
    w_scale = IDX_HEADS ** -0.5
    kpos = jnp.arange(S)
    bidx = jnp.arange(B)[:, None, None]

    def block(i):
        start = i * Q_BLOCK
        qb = lax.dynamic_slice_in_dim(q, start, Q_BLOCK, axis=1)
        qib = lax.dynamic_slice_in_dim(q_idx, start, Q_BLOCK, axis=1)
        wb = lax.dynamic_slice_in_dim(w_idx, start, Q_BLOCK, axis=1).astype(jnp.float32) * w_scale
        qpos = start + jnp.arange(Q_BLOCK)
        logits = jnp.einsum('bthd,bsd->bths', qib, k_idx, preferred_element_type=jnp.float32) * idx_scale
        score = jnp.einsum('bths,bth->bts', jax.nn.relu(logits), wb)
        score = jnp.where(kpos[None, :] <= qpos[:, None], score, -jnp.inf)
        _, sel = lax.top_k(score, topk)
        k_sel = k[bidx, sel]
        v_sel = v[bidx, sel]
        s = jnp.einsum('bthd,btkd->bhtk', qb, k_sel, preferred_element_type=jnp.float32) * scale
        valid = sel <= qpos[None, :, None]
        s = jnp.where(valid[:, None], s, -jnp.inf)
        p = jax.nn.softmax(s, axis=-1).astype(v.dtype)
        return jnp.einsum('bhtk,btkd->bthd', p, v_sel)

    out = lax.map(block, jnp.arange(S // Q_BLOCK))
    return out.transpose(1, 0, 2, 3, 4).reshape(B, S, H, hd)


def peer(x, w_q, keys1, keys2, u, v):
    B, S, D = x.shape
    T = B * S
    xt = x.reshape(T, D)
    q = (xt @ w_q).reshape(T, PEER_HEADS, 2, PEER_SUBDIM)
    s1 = jnp.einsum('thd,hnd->thn', q[:, :, 0], keys1, preferred_element_type=jnp.float32)
    s2 = jnp.einsum('thd,hnd->thn', q[:, :, 1], keys2, preferred_element_type=jnp.float32)
    v1, i1 = lax.top_k(s1, PEER_TOPK)
    v2, i2 = lax.top_k(s2, PEER_TOPK)
    cand = (v1[..., :, None] + v2[..., None, :]).reshape(T, PEER_HEADS, PEER_TOPK * PEER_TOPK)
    cand_idx = (i1[..., :, None] * PEER_NKEYS + i2[..., None, :]).reshape(T, PEER_HEADS, PEER_TOPK * PEER_TOPK)
    best, pos = lax.top_k(cand, PEER_TOPK)
    expert = jnp.take_along_axis(cand_idx, pos, axis=-1)
    gate = jax.nn.softmax(best, axis=-1)
    nb = T // PEER_TOK_BLOCK

    def block(args):
        xb, eb, gb = args
        ub = u[eb]
        h = jnp.einsum('td,thkd->thk', xb, ub, preferred_element_type=jnp.float32)
        a = (gb * jax.nn.gelu(h, approximate=False)).astype(xb.dtype)
        return jnp.einsum('thk,thkd->td', a, v[eb])

    out = lax.map(block, (xt.reshape(nb, PEER_TOK_BLOCK, D),
                          expert.reshape(nb, PEER_TOK_BLOCK, PEER_HEADS, PEER_TOPK),
                          gate.reshape(nb, PEER_TOK_BLOCK, PEER_HEADS, PEER_TOPK)))
    return out.reshape(B, S, D)


def setup_inputs(seed: int = 0) -> dict:
    key = jax.random.key(seed)
    ks = jax.random.split(key, 16)
    f32 = jnp.float32
    n = lambda k, shape, s: jax.random.normal(k, shape, f32) * s
    return {
        "x": jax.random.normal(ks[0], (BATCH, SEQ, D_MODEL), f32),
        "positions": jnp.broadcast_to(jnp.arange(SEQ, dtype=jnp.int32), (BATCH, SEQ)),
        "ln1_g": 1.0 + n(ks[1], (DEPTH, D_MODEL), 0.02),
        "w_in": n(ks[2], (DEPTH, D_MODEL, IN_WIDTH), D_MODEL ** -0.5),
        "fox_forget_b": jax.random.uniform(ks[3], (DEPTH, FOX_HEADS), f32, 1.0, 5.0),
        "fox_qn_g": 1.0 + n(ks[4], (DEPTH, HEAD_DIM), 0.02),
        "fox_kn_g": 1.0 + n(ks[5], (DEPTH, HEAD_DIM), 0.02),
        "dsa_qn_g": 1.0 + n(ks[6], (DEPTH, HEAD_DIM), 0.02),
        "dsa_kn_g": 1.0 + n(ks[7], (DEPTH, HEAD_DIM), 0.02),
        "w_o": n(ks[8], (DEPTH, MIX_WIDTH, D_MODEL), MIX_WIDTH ** -0.5),
        "ln2_g": 1.0 + n(ks[9], (DEPTH, D_MODEL), 0.02),
        "peer_wq": n(ks[10], (DEPTH, D_MODEL, PEER_HEADS * PEER_QDIM), D_MODEL ** -0.5),
        "peer_keys1": n(ks[11], (DEPTH, PEER_HEADS, PEER_NKEYS, PEER_SUBDIM), PEER_SUBDIM ** -0.5),
        "peer_keys2": n(ks[12], (DEPTH, PEER_HEADS, PEER_NKEYS, PEER_SUBDIM), PEER_SUBDIM ** -0.5),
        "peer_u": n(ks[13], (DEPTH, PEER_EXPERTS, D_MODEL), D_MODEL ** -0.5),
        "peer_v": n(ks[14], (DEPTH, PEER_EXPERTS, D_MODEL), (PEER_HEADS * PEER_TOPK) ** -0.5),
    }


def reference(x, positions, ln1_g, w_in, fox_forget_b, fox_qn_g, fox_kn_g, dsa_qn_g, dsa_kn_g,
              w_o, ln2_g, peer_wq, peer_keys1, peer_keys2, peer_u, peer_v):
    B, S, D = x.shape
    topk = min(DSA_TOPK_MAX, S // 4)
    splits = _split_points(IN_SIZES)
    for l in range(DEPTH):
        h = rmsnorm(x, ln1_g[l])
        proj = h @ w_in[l]
        fq, fk, fv, ff, dq, dk, dv, iq, ik, iw = jnp.split(proj, splits, axis=-1)
        fq = rmsnorm(fq.reshape(B, S, FOX_HEADS, HEAD_DIM), fox_qn_g[l])
        fk = rmsnorm(fk.reshape(B, S, FOX_HEADS, HEAD_DIM), fox_kn_g[l])
        fv = fv.reshape(B, S, FOX_HEADS, HEAD_DIM)
        log_f = jax.nn.log_sigmoid(ff.astype(jnp.float32) + fox_forget_b[l].astype(jnp.float32))
        fox_out = fox_attention(fq, fk, fv, log_f)
        dq = rope(rmsnorm(dq.reshape(B, S, DSA_HEADS, HEAD_DIM), dsa_qn_g[l]), positions)
        dk = rope(rmsnorm(dk.reshape(B, S, 1, HEAD_DIM), dsa_kn_g[l]), positions)[:, :, 0]
        iq = rope(iq.reshape(B, S, IDX_HEADS, IDX_DIM), positions)
        ik = rope(ik.reshape(B, S, 1, IDX_DIM), positions)[:, :, 0]
        dsa_out = dsa_attention(dq, dk, dv, iq, ik, iw, topk)
        mix = jnp.concatenate([fox_out.reshape(B, S, FOX_WIDTH), dsa_out.reshape(B, S, DSA_WIDTH)], axis=-1)
        x = x + mix @ w_o[l]
        h2 = rmsnorm(x, ln2_g[l])
        x = x + peer(h2, peer_wq[l], peer_keys1[l], peer_keys2[l], peer_u[l], peer_v[l])
    return x
```

```cpp
#include <hip/hip_runtime.h>
#include <hip/hip_cooperative_groups.h>
#include <cstdio>
#include <cstdint>
namespace cg = cooperative_groups;


typedef unsigned short bf16_t;
typedef short bf16x8 __attribute__((ext_vector_type(8)));
typedef float f32x4 __attribute__((ext_vector_type(4)));
typedef unsigned u32x4 __attribute__((ext_vector_type(4)));
typedef unsigned u32x2 __attribute__((ext_vector_type(2)));
typedef __bf16 bf2_t __attribute__((ext_vector_type(2)));
typedef unsigned long long u64;

constexpr int S = 8192, D = 4096, HD = 128, NH = 16;
constexpr int NIN = 9568, NINP = 9728;
constexpr int NT = 512, NWV = 8;
constexpr float QSCALE = 0.08838834764831845f * 1.4426950408889634f;
constexpr float NEG_INF = -__builtin_inff();

constexpr size_t O_WTIN = 0;
constexpr size_t O_WTO  = O_WTIN + (size_t)NINP * D * 2;
constexpr size_t O_WTQ  = O_WTO + (size_t)D * D * 2;
constexpr size_t O_H    = O_WTQ + (size_t)1024 * D * 2;
constexpr size_t O_MIX  = O_H + (size_t)S * D * 2;
constexpr size_t O_FQ   = O_MIX + (size_t)S * D * 2;
constexpr size_t O_FK   = O_FQ + (size_t)NH * S * HD * 2;
constexpr size_t O_FVT  = O_FK + (size_t)NH * S * HD * 2;
constexpr size_t O_DQ   = O_FVT + (size_t)NH * S * HD * 2;
constexpr size_t O_DK   = O_DQ + (size_t)S * NH * HD * 2;
constexpr size_t O_DV   = O_DK + (size_t)S * HD * 2;
constexpr size_t O_IQ   = O_DV + (size_t)S * HD * 2;
constexpr size_t O_IK   = O_IQ + (size_t)S * 16 * 64 * 2;
constexpr size_t O_IW   = O_IK + (size_t)S * 64 * 2;
constexpr size_t O_LOGF = O_IW + (size_t)S * 16 * 4;
constexpr size_t O_CUM  = O_LOGF + (size_t)16 * S * 4;
constexpr size_t O_QP   = O_CUM + (size_t)16 * S * 4;
constexpr size_t O_K1   = O_QP + (size_t)S * 1024 * 2;
constexpr size_t O_K2   = O_K1 + (size_t)8 * 128 * 64 * 2;
constexpr size_t O_SC   = O_K2 + (size_t)8 * 128 * 64 * 2;
constexpr size_t O_PROJ = O_SC;
constexpr size_t O_H2   = O_SC + (size_t)S * S * 4;
constexpr size_t O_UB   = O_H2 + (size_t)S * D * 2;
constexpr size_t O_VB   = O_UB + (size_t)16384 * 3072;
constexpr size_t WS_TOTAL = O_VB + (size_t)16384 * 3072;
constexpr size_t O_PART = WS_TOTAL;
constexpr size_t O_CTR  = O_PART + (size_t)S * 64 * 4;
constexpr size_t O_XB   = O_CTR + 256;
constexpr size_t WS_TOTAL2 = O_XB + 3456 * 4;
constexpr float U_SCALE = 96.f, V_SCALE = 16.f;
typedef float v16f_t __attribute__((ext_vector_type(16)));
typedef float v32f_t __attribute__((ext_vector_type(32)));
typedef unsigned v6u_t __attribute__((ext_vector_type(6)));

struct Params {
    const float* x; const int* pos; const float* ln1; const float* w_in; const float* fb; const float* fqg; const float* fkg;
    const float* dqg; const float* dkg; const float* w_o; const float* ln2; const float* wq; const float* k1; const float* k2;
    const float* u; const float* v; float* out; char* ws;
};

typedef float f32x2 __attribute__((ext_vector_type(2)));
__device__ __forceinline__ unsigned pk_bf16(float lo, float hi) { const f32x2 v = {lo, hi}; return __builtin_bit_cast(unsigned, __builtin_convertvector(v, bf2_t)); }
__device__ __forceinline__ bf16_t f2bf(float f) { return (bf16_t)(pk_bf16(f, 0.f) & 0xffffu); }
__device__ __forceinline__ float bf_lo(unsigned u) { return __uint_as_float(u << 16); }
__device__ __forceinline__ float bf_hi(unsigned u) { return __uint_as_float(u & 0xffff0000u); }
__device__ __forceinline__ float wave_sum(float v) {
#define DPPF_(x, ctrl) __builtin_bit_cast(float, __builtin_amdgcn_update_dpp(0, __builtin_bit_cast(int, x), ctrl, 0xf, 0xf, true))
    v += DPPF_(v, 0x111); v += DPPF_(v, 0x112); v += DPPF_(v, 0x114); v += DPPF_(v, 0x118);
#undef DPPF_
    const int vi = __builtin_bit_cast(int, v);
    return (__builtin_bit_cast(float, __builtin_amdgcn_readlane(vi, 15)) + __builtin_bit_cast(float, __builtin_amdgcn_readlane(vi, 31))) +
           (__builtin_bit_cast(float, __builtin_amdgcn_readlane(vi, 47)) + __builtin_bit_cast(float, __builtin_amdgcn_readlane(vi, 63)));
}
__device__ __forceinline__ unsigned f2key(float f) { const unsigned u = __float_as_uint(f); return (u & 0x80000000u) ? ~u : (u | 0x80000000u); }
__device__ __forceinline__ u64 ballot(bool p) { return __builtin_amdgcn_ballot_w64(p); }
__device__ __forceinline__ int popc(u64 m) { return __builtin_popcountll(m); }
__device__ __forceinline__ f32x4 mfma(bf16x8 a, bf16x8 b, f32x4 c) { return __builtin_amdgcn_mfma_f32_16x16x32_bf16(a, b, c, 0, 0, 0); }
__device__ __forceinline__ float fdot2(unsigned a, unsigned b, float c) {
    return __builtin_amdgcn_fdot2_f32_bf16(__builtin_bit_cast(bf2_t, a), __builtin_bit_cast(bf2_t, b), c, false);
}
__device__ __forceinline__ void sincos_f(float ang, float& s, float& c) {
    double t = (double)ang * 0.15915494309189535; t -= rint(t);
    const float f = (float)t; s = __builtin_amdgcn_sinf(f); c = __builtin_amdgcn_cosf(f);
}
__device__ __forceinline__ float block_sum(float v, float* red) {
    v = wave_sum(v);
    __syncthreads();
    if ((threadIdx.x & 63) == 0) red[threadIdx.x >> 6] = v;
    __syncthreads();
    return ((red[0] + red[1]) + (red[2] + red[3])) + ((red[4] + red[5]) + (red[6] + red[7]));
}
__device__ __forceinline__ int in_src_col(int n) {
    if (n < 6144) return n;
    if (n < 9536) return n + 16;
    if (n < 9552) return n - 9536 + 6144;
    if (n < 9568) return n;
    return -1;
}

#define TILE_JOB(it_, W_, Wt_, ldw_, n0_, k0_, mode_) do { int _t = (it_); \
    if (_t < T_IN) { W_ = P.w_in; Wt_ = (bf16_t*)(P.ws + O_WTIN); ldw_ = NIN; mode_ = 1; } \
    else if (_t < T_IN + T_O) { _t -= T_IN; W_ = P.w_o; Wt_ = (bf16_t*)(P.ws + O_WTO); ldw_ = D; mode_ = 0; } \
    else { _t -= T_IN + T_O; W_ = P.wq; Wt_ = (bf16_t*)(P.ws + O_WTQ); ldw_ = 1024; mode_ = 0; } \
    n0_ = (_t >> 5) * 64; k0_ = (_t & 31) * 128; } while (0)
#define TILE_LOAD(W_, ldw_, n0_, k0_, mode_) do { const int _sc = (mode_) ? in_src_col((n0_) + tx) : ((n0_) + tx); \
    _Pragma("unroll") for (int i = 0; i < 16; ++i) r[i] = _sc >= 0 ? (W_)[(size_t)((k0_) + i * 8 + ty) * (ldw_) + _sc] : 0.f; } while (0)
__device__ __forceinline__ void transpose_all(const Params& P, char* smem) {
    constexpr int T_IN = (NINP / 64) * 32, T_O = 64 * 32, TOTAL = T_IN + T_O + 16 * 32;
    float* T = (float*)smem;
    const int tid = threadIdx.x, tx = tid & 63, ty = tid >> 6;
    int it = blockIdx.x;
    if (it >= TOTAL) return;
    const float* W; bf16_t* Wt; int ldw, n0, k0, mode;
    TILE_JOB(it, W, Wt, ldw, n0, k0, mode);
    float r[16];
    TILE_LOAD(W, ldw, n0, k0, mode);
    for (;;) {
#pragma unroll
        for (int i = 0; i < 16; ++i) T[(i * 8 + ty) * 65 + tx] = r[i];
        __syncthreads();
        bf16_t* cWt = Wt; const int cn0 = n0, ck0 = k0;
        const int nit = it + gridDim.x;
        const bool more = nit < TOTAL;
        if (more) { TILE_JOB(nit, W, Wt, ldw, n0, k0, mode); TILE_LOAD(W, ldw, n0, k0, mode); }
#pragma unroll
        for (int i = 0; i < 8; ++i) {
            const int n = i * 8 + ty, k = tx * 2;
            *(unsigned*)(cWt + (size_t)(cn0 + n) * D + ck0 + k) = pk_bf16(T[k * 65 + n], T[(k + 1) * 65 + n]);
        }
        __syncthreads();
        if (!more) break;
        it = nit;
    }
}
#undef TILE_JOB
#undef TILE_LOAD
__device__ __forceinline__ void rmsnorm_rows(const float* __restrict__ X, const float* __restrict__ gn, bf16_t* __restrict__ dst) {
    const int lane = threadIdx.x & 63, w = threadIdx.x >> 6;
    for (int row = blockIdx.x * NWV + w; row < S; row += gridDim.x * NWV) {
        const f32x4* xr = (const f32x4*)(X + (size_t)row * D) + lane;
        f32x4 v[16]; float ss = 0.f;
#pragma unroll
        for (int i = 0; i < 16; ++i) { v[i] = xr[i * 64]; ss += v[i][0] * v[i][0] + v[i][1] * v[i][1] + v[i][2] * v[i][2] + v[i][3] * v[i][3]; }
        ss = wave_sum(ss);
        const float r = rsqrtf(ss * (1.0f / 4096.0f) + 1e-6f);
        u32x2* dr = (u32x2*)(dst + (size_t)row * D) + lane;
#pragma unroll
        for (int i = 0; i < 16; ++i) {
            const f32x4 gg = ((const f32x4*)gn)[i * 64 + lane];
            u32x2 o; o.x = pk_bf16(v[i][0] * r * gg[0], v[i][1] * r * gg[1]); o.y = pk_bf16(v[i][2] * r * gg[2], v[i][3] * r * gg[3]);
            dr[i * 64] = o;
        }
    }
}

__device__ __forceinline__ void phase0(const Params& P, char* smem) {
    char* ws = P.ws;
    rmsnorm_rows(P.x, P.ln1, (bf16_t*)(ws + O_H));
    transpose_all(P, smem);
    bf16_t* K1 = (bf16_t*)(ws + O_K1); bf16_t* K2 = (bf16_t*)(ws + O_K2);
    for (int i = blockIdx.x * NT + threadIdx.x; i < 8 * 128 * 64; i += gridDim.x * NT) {
        const int hd = i >> 13, n = (i >> 6) & 127, d = i & 63;
        const int o = ((hd * 8 + (d >> 3)) * 128 + n) * 8 + (d & 7);
        K1[o] = f2bf(P.k1[i]); K2[o] = f2bf(P.k2[i]);
    }
}

namespace pg8 {
#define PG8_LAS __attribute__((address_space(3)))
typedef unsigned short bf16_t;
typedef short bf16x8 __attribute__((ext_vector_type(8)));
typedef float f32x4 __attribute__((ext_vector_type(4)));
typedef unsigned u32x4 __attribute__((ext_vector_type(4)));
constexpr int BM = 256, BK = 64, HALF = 128, HTB = HALF * BK * 2  , STAGE_BYTES = 8 * HTB, NXCD = 8, WGM = 8;

__host__ __device__ __forceinline__ int lds_byte(int r, int c) { const int st = (r >> 4) * 2 + (c >> 5), rr = r & 15, cc = c & 31, ob = rr * 64 + cc * 2; return st * 1024 + (ob ^ (((ob >> 9) & 1) << 5)); }
__host__ __device__ __forceinline__ void stage_rc(int b, int& R, int& C) { const int st = b / 1024, sb = b % 1024, swz = sb ^ (((sb >> 9) & 1) << 5); R = (st >> 1) * 16 + swz / 64; C = (st & 1) * 32 + (swz % 64) / 2; }
__host__ __device__ __forceinline__ int perm32(int rho) { const int n = rho >> 4, i = rho & 15; return 8 * (i >> 2) + 4 * n + (i & 3); }

struct Unit { int pm, pn; };
struct Gemm { const bf16_t* A; const bf16_t* Bt; int M, N, K; };

struct StaticOrder {
    int nM, nN, nwg, G, c;
    __host__ __device__ void init(int M, int N, int G_, int c_) { nM = M / BM; nN = N / BM; nwg = nM * nN; G = G_; c = c_; }
    __host__ __device__ bool next(int i, Unit& u) const {
        const long L = (long)i * G + c; if (L >= nwg) return false;
        int wgid = (int)L; { const int q = nwg / NXCD, r = nwg % NXCD, xcd = wgid % NXCD, off = wgid / NXCD; wgid = (xcd < r ? xcd * (q + 1) : r * (q + 1) + (xcd - r) * q) + off; }
        const int nig = WGM * nN, gid = wgid / nig, fm = gid * WGM, gsz = (nM - fm) < WGM ? (nM - fm) : WGM;
        u.pm = fm + ((wgid % nig) % gsz); u.pn = (wgid % nig) / gsz; return true;
    }
    __device__ __forceinline__ void a_ready(const Unit&) const {}
    __device__ __forceinline__ void done(const Unit&) const {}
};


__device__ __forceinline__ unsigned epk(float lo, float hi) { typedef float v2f __attribute__((ext_vector_type(2))); typedef __bf16 v2b __attribute__((ext_vector_type(2))); const v2f v = {lo, hi}; return __builtin_bit_cast(unsigned, __builtin_convertvector(v, v2b)); }
struct EpiInProj {
    static constexpr bool PERM = true, AFTER_DRAIN = false;
    bf16_t* proj; bf16_t* fvt; int ldp; int seq;
    __device__ __forceinline__ void operator()(const f32x4 (&acc)[2][2][4][2], const Unit& u, int wr, int wc, int fr, int fq) const {
        if (u.pn >= 16 && u.pn < 24) {
#pragma unroll
            for (int ai = 0; ai < 2; ++ai)
#pragma unroll
                for (int bj = 0; bj < 2; ++bj)
#pragma unroll
                    for (int m = 0; m < 4; ++m) {
                        const size_t r = (size_t)u.pm * BM + ai * HALF + wr * 64 + m * 16 + fr;
#pragma unroll
                        for (int n = 0; n < 2; ++n)
#pragma unroll
                            for (int j = 0; j < 4; ++j) {
                                const size_t d = (size_t)((u.pn - 16) * 2 + bj) * 128 + wc * 32 + fq * 8 + n * 4 + j;
                                fvt[d * seq + r] = (bf16_t)(epk(acc[ai][bj][m][n][j], 0.f) & 0xffffu);
                            }
                    }
        } else {
#pragma unroll
            for (int ai = 0; ai < 2; ++ai)
#pragma unroll
                for (int m = 0; m < 4; ++m) {
                    bf16_t* rowp = proj + ((size_t)u.pm * BM + ai * HALF + wr * 64 + m * 16 + fr) * ldp + u.pn * BM + wc * 32 + fq * 8;
#pragma unroll
                    for (int bj = 0; bj < 2; ++bj) {
                        u32x4 w;
                        w.x = epk(acc[ai][bj][m][0][0], acc[ai][bj][m][0][1]); w.y = epk(acc[ai][bj][m][0][2], acc[ai][bj][m][0][3]);
                        w.z = epk(acc[ai][bj][m][1][0], acc[ai][bj][m][1][1]); w.w = epk(acc[ai][bj][m][1][2], acc[ai][bj][m][1][3]);
                        *(u32x4*)(rowp + bj * HALF) = w;
                    }
                }
        }
    }
};
struct EpiResid {
    static constexpr bool PERM = true, AFTER_DRAIN = false;
    const float* x; float* out; int ld; const float* g2; bf16_t* a2; float* part;
    __device__ __forceinline__ void operator()(const f32x4 (&acc)[2][2][4][2], const Unit& u, int wr, int wc, int fr, int fq) const {
        f32x4 gv[2][2];
#pragma unroll
        for (int bj = 0; bj < 2; ++bj)
#pragma unroll
            for (int n = 0; n < 2; ++n) gv[bj][n] = *(const f32x4*)(g2 + u.pn * BM + wc * 32 + fq * 8 + bj * HALF + n * 4);
#pragma unroll
        for (int ai = 0; ai < 2; ++ai)
#pragma unroll
            for (int m = 0; m < 4; ++m) {
                const size_t row = (size_t)u.pm * BM + ai * HALF + wr * 64 + m * 16 + fr;
                const size_t o = row * ld + u.pn * BM + wc * 32 + fq * 8;
                float ss = 0.f;
#pragma unroll
                for (int bj = 0; bj < 2; ++bj) {
                    u32x4 w;
#pragma unroll
                    for (int n = 0; n < 2; ++n) {
                        const f32x4 v = *(const f32x4*)(x + o + bj * HALF + n * 4) + acc[ai][bj][m][n];
                        *(f32x4*)(out + o + bj * HALF + n * 4) = v;
                        ss += (v[0] * v[0] + v[1] * v[1]) + (v[2] * v[2] + v[3] * v[3]);
                        const f32x4 gq = v * gv[bj][n];
                        w[2 * n] = epk(gq[0], gq[1]); w[2 * n + 1] = epk(gq[2], gq[3]);
                    }
                    *(u32x4*)(a2 + o + bj * HALF) = w;
                }
                ss += __shfl_xor(ss, 16); ss += __shfl_xor(ss, 32);
                if (fq == 0) part[row * 64 + u.pn * 4 + wc] = ss;
            }
    }
};
struct EpiStoreBf16 {
    static constexpr bool PERM = true, AFTER_DRAIN = false;
    bf16_t* O; int ld;
    __device__ __forceinline__ void operator()(const f32x4 (&acc)[2][2][4][2], const Unit& u, int wr, int wc, int fr, int fq) const {
#pragma unroll
        for (int ai = 0; ai < 2; ++ai)
#pragma unroll
            for (int m = 0; m < 4; ++m) {
                bf16_t* rowp = O + ((size_t)u.pm * BM + ai * HALF + wr * 64 + m * 16 + fr) * ld + u.pn * BM + wc * 32 + fq * 8;
#pragma unroll
                for (int bj = 0; bj < 2; ++bj) {
                    u32x4 w;
                    w.x = epk(acc[ai][bj][m][0][0], acc[ai][bj][m][0][1]); w.y = epk(acc[ai][bj][m][0][2], acc[ai][bj][m][0][3]);
                    w.z = epk(acc[ai][bj][m][1][0], acc[ai][bj][m][1][1]); w.w = epk(acc[ai][bj][m][1][2], acc[ai][bj][m][1][3]);
                    *(u32x4*)(rowp + bj * HALF) = w;
                }
            }
    }
};

template <class Epi, class Sched, bool ALIGN_EPI = false, bool SP2 = false>
__device__ __forceinline__ void gemm_phase(PG8_LAS unsigned char* lds, const Gemm g, const Sched& S, const Epi& E) {
    const int tid = threadIdx.x, wid = __builtin_amdgcn_readfirstlane(tid >> 6), lane = tid & 63, wr = wid >> 2, wc = wid & 3, fr = lane & 15, fq = lane >> 4;
    const int K = g.K, nt = K / BK;
    unsigned voffA[2], voffB[2];
#pragma unroll
    for (int i = 0; i < 2; ++i) { int R, C; stage_rc(tid * 16 + i * 8192, R, C); const int Rb = Epi::PERM ? ((R & ~31) + perm32(R & 31)) : R;
        voffA[i] = (unsigned)(R * K + C) * 2u; voffB[i] = (unsigned)(Rb * K + C) * 2u; }
    const size_t kstep = (size_t)(BK * 2);
    const size_t hstep = (size_t)HALF * K * 2;
    const size_t tstep = 2 * hstep;
    const unsigned ldsw = (unsigned)wid * 1024u;
    const int aoff = lds_byte(wr * 64 + fr, fq * 8), boff = lds_byte(wc * 32 + fr, fq * 8);
#define PG8_SA(b, h) (((b) * 2 + (h)) * HTB)
#define PG8_SB(b, h) ((4 + (b) * 2 + (h)) * HTB)
#define PG8_STAGE(bufoff, gbase, voff) do { _Pragma("unroll") for (int _i = 0; _i < 2; ++_i) \
        __builtin_amdgcn_global_load_lds((const unsigned*)((const char*)(gbase) + (voff)[_i]), (PG8_LAS unsigned*)(lds + (bufoff) + ldsw + _i * 8192), 16, 0, 0); } while (0)
#define PG8_LDA(dst, b, h) do { _Pragma("unroll") for (int m = 0; m < 4; ++m) _Pragma("unroll") for (int k = 0; k < 2; ++k) dst[m][k] = *(const PG8_LAS bf16x8*)(lds + PG8_SA(b, h) + aoff + m * 2048 + k * 1024); } while (0)
#define PG8_LDB(dst, b, h) do { _Pragma("unroll") for (int n = 0; n < 2; ++n) _Pragma("unroll") for (int k = 0; k < 2; ++k) dst[n][k] = *(const PG8_LAS bf16x8*)(lds + PG8_SB(b, h) + boff + n * 2048 + k * 1024); } while (0)
#define PG8_MMA(ai, bj, At, Bt) do { __builtin_amdgcn_s_setprio(1); _Pragma("unroll") for (int m = 0; m < 4; ++m) _Pragma("unroll") for (int n = 0; n < 2; ++n) _Pragma("unroll") for (int k = 0; k < 2; ++k) \
        acc[ai][bj][m][n] = __builtin_amdgcn_mfma_f32_16x16x32_bf16(Bt[n][k], At[m][k], acc[ai][bj][m][n], 0, 0, 0); __builtin_amdgcn_s_setprio(0); } while (0)
#define PG8_WAIT_V(n) asm volatile("s_waitcnt vmcnt(" #n ")" ::: "memory")
#define PG8_WAIT_L(n) asm volatile("s_waitcnt lgkmcnt(" #n ")" ::: "memory")
#define PG8_BAR __builtin_amdgcn_s_barrier()
#define PG8_SCHED __builtin_amdgcn_sched_barrier(0)
    Unit cur, nxt; int ui = 0;
    if (!S.next(0, cur)) return;
    f32x4 acc[2][2][4][2];
#pragma unroll
    for (int a = 0; a < 2; ++a)
#pragma unroll
        for (int b = 0; b < 2; ++b)
#pragma unroll
            for (int m = 0; m < 4; ++m)
#pragma unroll
                for (int n = 0; n < 2; ++n) acc[a][b][m][n] = (f32x4){0.f, 0.f, 0.f, 0.f};
    bf16x8 At[4][2], B0[2][2], B1[2][2];
    const char* cA = (const char*)g.A + (size_t)cur.pm * tstep; const char* cB = (const char*)g.Bt + (size_t)cur.pn * tstep;
    S.a_ready(cur);
    if constexpr (SP2) {
        PG8_STAGE(PG8_SB(0, 0), cB, voffB); PG8_STAGE(PG8_SB(0, 1), cB + hstep, voffB); PG8_STAGE(PG8_SA(0, 0), cA, voffA); PG8_STAGE(PG8_SA(0, 1), cA + hstep, voffA);
        if (wr == 1) PG8_BAR;
        PG8_WAIT_V(2); PG8_BAR;
        PG8_STAGE(PG8_SB(1, 0), cB + kstep, voffB); PG8_STAGE(PG8_SA(1, 0), cA + kstep, voffA); PG8_STAGE(PG8_SB(1, 1), cB + hstep + kstep, voffB);
        PG8_WAIT_V(6); PG8_BAR;
    } else {
        PG8_STAGE(PG8_SB(0, 0), cB, voffB); PG8_STAGE(PG8_SA(0, 0), cA, voffA); PG8_STAGE(PG8_SB(0, 1), cB + hstep, voffB); PG8_STAGE(PG8_SA(0, 1), cA + hstep, voffA);
        if (wr == 1) PG8_BAR;
        PG8_WAIT_V(4); PG8_BAR;
        PG8_STAGE(PG8_SB(1, 0), cB + kstep, voffB); PG8_STAGE(PG8_SA(1, 0), cA + kstep, voffA); PG8_STAGE(PG8_SB(1, 1), cB + hstep + kstep, voffB);
        PG8_WAIT_V(6); PG8_BAR;
    }
    for (;;) {
        const bool has_next = S.next(ui + 1, nxt);
        const char* nA = has_next ? (const char*)g.A + (size_t)nxt.pm * tstep : cA; const char* nB = has_next ? (const char*)g.Bt + (size_t)nxt.pn * tstep : cB;
        for (int t = 0; t < nt; t += 2) {
            const bool last = (t == nt - 2);
            const char* a1 = cA + (size_t)(t + 1) * kstep;
            const char* a2 = last ? nA : cA + (size_t)(t + 2) * kstep; const char* b2 = last ? nB : cB + (size_t)(t + 2) * kstep;
            const char* a3 = a2 + kstep; const char* b3 = b2 + kstep;
            if (last && has_next) S.a_ready(nxt);
            if constexpr (SP2) {
            PG8_LDB(B0, 0, 0); PG8_LDB(B1, 0, 1); PG8_SCHED; PG8_LDA(At, 0, 0); PG8_STAGE(PG8_SA(1, 1), a1 + hstep, voffA);
            PG8_WAIT_V(8); PG8_WAIT_L(0); PG8_BAR; PG8_MMA(0, 0, At, B0); PG8_MMA(0, 1, At, B1); PG8_BAR; PG8_SCHED;
            PG8_LDA(At, 0, 1); PG8_STAGE(PG8_SB(0, 0), b2, voffB); PG8_STAGE(PG8_SB(0, 1), b2 + hstep, voffB); PG8_STAGE(PG8_SA(0, 0), a2, voffA);
            PG8_WAIT_V(8); PG8_WAIT_L(0); PG8_BAR; PG8_MMA(1, 0, At, B0); PG8_MMA(1, 1, At, B1); PG8_BAR; PG8_SCHED;
            PG8_LDB(B0, 1, 0); PG8_LDB(B1, 1, 1); PG8_SCHED; PG8_LDA(At, 1, 0); PG8_STAGE(PG8_SA(0, 1), a2 + hstep, voffA);
            PG8_WAIT_V(8); PG8_WAIT_L(0); PG8_BAR; PG8_MMA(0, 0, At, B0); PG8_MMA(0, 1, At, B1); PG8_BAR; PG8_SCHED;
            PG8_LDA(At, 1, 1); PG8_STAGE(PG8_SB(1, 0), b3, voffB); PG8_STAGE(PG8_SB(1, 1), b3 + hstep, voffB); PG8_STAGE(PG8_SA(1, 0), a3, voffA);
            PG8_WAIT_V(8); PG8_WAIT_L(0); PG8_BAR; PG8_MMA(1, 0, At, B0); PG8_MMA(1, 1, At, B1); PG8_BAR; PG8_SCHED;
            } else {
            PG8_LDB(B0, 0, 0); PG8_SCHED; PG8_LDA(At, 0, 0); PG8_STAGE(PG8_SA(1, 1), a1 + hstep, voffA);
            PG8_WAIT_L(8); PG8_BAR; PG8_WAIT_L(0); PG8_MMA(0, 0, At, B0); PG8_BAR; PG8_SCHED;
            PG8_LDB(B1, 0, 1); PG8_STAGE(PG8_SB(0, 0), b2, voffB);
            PG8_BAR; PG8_WAIT_L(0); PG8_MMA(0, 1, At, B1); PG8_BAR;
            PG8_LDA(At, 0, 1); PG8_STAGE(PG8_SA(0, 0), a2, voffA);
            PG8_BAR; PG8_WAIT_L(0); PG8_MMA(1, 0, At, B0); PG8_BAR; PG8_SCHED;
            PG8_STAGE(PG8_SB(0, 1), b2 + hstep, voffB);
            PG8_WAIT_V(6); PG8_BAR; PG8_MMA(1, 1, At, B1); PG8_BAR;
            PG8_LDB(B0, 1, 0); PG8_SCHED; PG8_LDA(At, 1, 0); PG8_STAGE(PG8_SA(0, 1), a2 + hstep, voffA);
            PG8_WAIT_L(8); PG8_BAR; PG8_WAIT_L(0); PG8_MMA(0, 0, At, B0); PG8_BAR; PG8_SCHED;
            PG8_LDB(B1, 1, 1); PG8_STAGE(PG8_SB(1, 0), b3, voffB);
            PG8_BAR; PG8_WAIT_L(0); PG8_MMA(0, 1, At, B1); PG8_BAR;
            PG8_LDA(At, 1, 1); PG8_STAGE(PG8_SA(1, 0), a3, voffA);
            PG8_BAR; PG8_WAIT_L(0); PG8_MMA(1, 0, At, B0); PG8_BAR; PG8_SCHED;
            PG8_STAGE(PG8_SB(1, 1), b3 + hstep, voffB);
            PG8_WAIT_V(6); PG8_BAR; PG8_MMA(1, 1, At, B1); PG8_BAR;
            }
        }
        if constexpr (ALIGN_EPI) { if (wr == 0) PG8_BAR; }
        if constexpr (!Epi::AFTER_DRAIN) { E(acc, cur, wr, wc, fr, fq); S.done(cur); }
        if (!has_next) break;
#pragma unroll
        for (int a = 0; a < 2; ++a)
#pragma unroll
            for (int b = 0; b < 2; ++b)
#pragma unroll
                for (int m = 0; m < 4; ++m)
#pragma unroll
                    for (int n = 0; n < 2; ++n) acc[a][b][m][n] = (f32x4){0.f, 0.f, 0.f, 0.f};
        cur = nxt; cA = nA; cB = nB; ++ui;
        if constexpr (ALIGN_EPI) { if (wr == 1) PG8_BAR; }
    }
    PG8_WAIT_V(0);
    if constexpr (!ALIGN_EPI) { if (wr == 0) PG8_BAR; }
    PG8_BAR;
    if constexpr (Epi::AFTER_DRAIN) { E.fused(acc, cur, wr, wc, fr, fq, lds, wid, lane); S.done(cur); }
#undef PG8_SA
#undef PG8_SB
#undef PG8_STAGE
#undef PG8_LDA
#undef PG8_LDB
#undef PG8_MMA
#undef PG8_WAIT_V
#undef PG8_WAIT_L
#undef PG8_BAR
#undef PG8_SCHED
}
}

constexpr int NCHUNK = 1024, NSPARE = 8;
__device__ __forceinline__ void convert_chunk(const Params& P, int c) {
    const bool isv = c >= 512; const int lc = c & 511;
    const float* src = (isv ? P.v : P.u);
    unsigned* dst = (unsigned*)(P.ws + (isv ? O_VB : O_UB));
    const float sc = isv ? V_SCALE : U_SCALE;
#pragma unroll 2
    for (int it = 0; it < 4; ++it) {
        const int si = lc * 2048 + it * NT + threadIdx.x;
        const int row = si >> 6, l = si & 63;
        const f32x4* sp = (const f32x4*)(src + (size_t)row * 4096 + 4 * l);
        v6u_t p[2];
#pragma unroll
        for (int h = 0; h < 2; ++h) {
            v16f_t a, b;
#pragma unroll
            for (int q = 0; q < 8; ++q) {
                const f32x4 x = sp[h * 512 + q * 64] * sc;
                a[2 * q] = x[0]; b[2 * q] = x[1]; a[2 * q + 1] = x[2]; b[2 * q + 1] = x[3];
            }
            p[h] = __builtin_amdgcn_cvt_scalef32_2xpk16_fp6_f32(a, b, 1.0f);
        }
        unsigned* rowp = dst + (size_t)row * 768;
        *(u32x4*)(rowp + 4 * l) = (u32x4){p[0][0], p[0][1], p[0][2], p[0][3]};
        *(u32x4*)(rowp + 256 + 4 * l) = (u32x4){p[0][4], p[0][5], p[1][0], p[1][1]};
        *(u32x4*)(rowp + 512 + 4 * l) = (u32x4){p[1][2], p[1][3], p[1][4], p[1][5]};
    }
}
__device__ __forceinline__ void convert_loop(const Params& P, char* smem, const bool stop_when_gemm_done) {
    unsigned* ctr = (unsigned*)(P.ws + O_CTR);
    int* slot = (int*)(smem + 131072);
    for (;;) {
        __syncthreads();
        if (threadIdx.x == 0) {
            int c = NCHUNK;
            if (!(stop_when_gemm_done && __hip_atomic_load(ctr + 57, __ATOMIC_RELAXED, __HIP_MEMORY_SCOPE_AGENT) != 0u)) c = (int)atomicAdd(ctr + 56, 1u);
            *slot = c;
        }
        __syncthreads();
        const int c = *slot;
        if (c >= NCHUNK) break;
        convert_chunk(P, c);
    }
}

template <int MODE>
__device__ __forceinline__ void gemm_phase(const Params& P, char* smem) {
    char* ws = P.ws;
    PG8_LAS unsigned char* lds = (PG8_LAS unsigned char*)smem;
    pg8::StaticOrder so;
    if (MODE == 0) {
        const int Gg = (int)gridDim.x - NSPARE;
        if ((int)blockIdx.x >= Gg) { convert_loop(P, smem, true); return; }
        pg8::Gemm g{(const bf16_t*)(ws + O_H), (const bf16_t*)(ws + O_WTIN), S, NINP, D}; so.init(S, NINP, Gg, blockIdx.x);
        pg8::EpiInProj E{(bf16_t*)(ws + O_PROJ), (bf16_t*)(ws + O_FVT), NINP, S};
        pg8::gemm_phase<pg8::EpiInProj, pg8::StaticOrder, true, true>(lds, g, so, E);
        if (threadIdx.x == 0) __hip_atomic_store((unsigned*)(ws + O_CTR) + 57, 1u, __ATOMIC_RELAXED, __HIP_MEMORY_SCOPE_AGENT);
    } else if (MODE == 1) {
        pg8::Gemm g{(const bf16_t*)(ws + O_MIX), (const bf16_t*)(ws + O_WTO), S, D, D}; so.init(S, D, gridDim.x, blockIdx.x);
        pg8::EpiResid E{P.x, P.out, D, P.ln2, (bf16_t*)(ws + O_H2), (float*)(ws + O_PART)};
        pg8::gemm_phase<pg8::EpiResid, pg8::StaticOrder, true, true>(lds, g, so, E);
    } else {
        pg8::Gemm g{(const bf16_t*)(ws + O_H2), (const bf16_t*)(ws + O_WTQ), S, 1024, D}; so.init(S, 1024, gridDim.x, blockIdx.x);
        pg8::EpiStoreBf16 E{(bf16_t*)(ws + O_QP), 1024};
        pg8::gemm_phase<pg8::EpiStoreBf16, pg8::StaticOrder, false, true>(lds, g, so, E);
        convert_loop(P, smem, false);
    }
}

__device__ __forceinline__ float row16_sum(float v) {
#define ROR_(x, n) __builtin_bit_cast(float, __builtin_amdgcn_update_dpp(0, __builtin_bit_cast(int, x), 0x120 + (n), 0xf, 0xf, true))
    v += ROR_(v, 8); v += ROR_(v, 4); v += ROR_(v, 2); v += ROR_(v, 1);
    return v;
}
__device__ __forceinline__ void post_phase(const Params& P) {
    char* ws = P.ws;
    const bf16_t* PROJ = (const bf16_t*)(ws + O_PROJ);
    const int lane = threadIdx.x & 63, w = threadIdx.x >> 6, li = lane & 15, gq = lane >> 4;
    const int nw = gridDim.x * NWV;
    constexpr int NPT = 59;
    float inv128v[8], inv64v[8];
#pragma unroll
    for (int e = 0; e < 8; ++e) {
        inv128v[e] = exp2f(-(float)((li & 7) * 8 + e) * (2.0f / 128.0f) * 13.287712379549449f);
        inv64v[e] = exp2f(-(float)((li & 3) * 8 + e) * (2.0f / 64.0f) * 13.287712379549449f);
    }
    for (int base = (blockIdx.x * NWV + w) * 4; base < NPT * S; base += nw * 4) {
        const int unit = base + gq;
        const int k = unit >> 13, row = unit & (S - 1);
        const int tn = k < 32 ? k : k + 16;
        const u32x4 rawv = *(const u32x4*)(PROJ + (size_t)row * NINP + tn * 128 + li * 8);
        float v[8];
#pragma unroll
        for (int q = 0; q < 4; ++q) { v[2 * q] = bf_lo(rawv[q]); v[2 * q + 1] = bf_hi(rawv[q]); }
        if (tn <= 64) {
            const float* gp = (tn < 16 ? P.fqg : tn < 32 ? P.fkg : tn < 64 ? P.dqg : P.dkg) + li * 8;
            const f32x4 ga = *(const f32x4*)gp, gb = *(const f32x4*)(gp + 4);
            float ss = 0.f;
#pragma unroll
            for (int e = 0; e < 8; ++e) ss += v[e] * v[e];
            ss = row16_sum(ss);
            const float r = rsqrtf(ss * (1.0f / 128.0f) + 1e-6f);
            float a[8];
#pragma unroll
            for (int e = 0; e < 8; ++e) a[e] = v[e] * r * (e < 4 ? ga[e] : gb[e - 4]);
            if (tn >= 48) {
                const float posf = (float)P.pos[row];
#pragma unroll
                for (int e = 0; e < 8; ++e) {
                    const float pr = ROR_(a[e], 8);
                    float sn, cs; sincos_f(posf * inv128v[e], sn, cs);
                    a[e] = li < 8 ? a[e] * cs - pr * sn : a[e] * cs + pr * sn;
                }
            }
            const float osc = (tn < 16 || (tn >= 48 && tn < 64)) ? QSCALE : 1.f;
            bf16_t* dst;
            if (tn < 16) dst = (bf16_t*)(ws + O_FQ) + ((size_t)tn * S + row) * 128;
            else if (tn < 32) dst = (bf16_t*)(ws + O_FK) + ((size_t)(tn - 16) * S + row) * 128;
            else if (tn < 64) dst = (bf16_t*)(ws + O_DQ) + ((size_t)row * 16 + (tn - 48)) * 128;
            else dst = (bf16_t*)(ws + O_DK) + (size_t)row * 128;
            u32x4 o;
#pragma unroll
            for (int q = 0; q < 4; ++q) o[q] = pk_bf16(a[2 * q] * osc, a[2 * q + 1] * osc);
            *(u32x4*)(dst + li * 8) = o;
        } else if (tn == 65) {
            *(u32x4*)((bf16_t*)(ws + O_DV) + (size_t)row * 128 + li * 8) = rawv;
        } else {
            const bool misc = tn == 74;
            if (!misc || li < 8) {
                const float posf = (float)P.pos[row];
                float a[8];
#pragma unroll
                for (int e = 0; e < 8; ++e) {
                    const float pr = __shfl_xor(v[e], 4);
                    float sn, cs; sincos_f(posf * inv64v[e], sn, cs);
                    a[e] = (li & 4) == 0 ? v[e] * cs - pr * sn : v[e] * cs + pr * sn;
                }
                u32x4 o;
#pragma unroll
                for (int q = 0; q < 4; ++q) o[q] = pk_bf16(a[2 * q], a[2 * q + 1]);
                bf16_t* dst = misc ? (bf16_t*)(ws + O_IK) + (size_t)row * 64 + li * 8
                                   : (bf16_t*)(ws + O_IQ) + ((size_t)row * 16 + (tn - 66) * 2 + (li >> 3)) * 64 + (li & 7) * 8;
                *(u32x4*)dst = o;
            } else if (li < 10) {
#pragma unroll
                for (int e = 0; e < 8; ++e) {
                    const int hh = (li - 8) * 8 + e;
                    const float z = v[e] + P.fb[hh];
                    ((float*)(ws + O_LOGF))[(size_t)hh * S + row] = fminf(z, 0.f) - log1pf(expf(-fabsf(z)));
                }
            } else if (li < 12) {
                float* dst = (float*)(ws + O_IW) + (size_t)row * 16 + (li - 10) * 8;
                *(f32x4*)dst = (f32x4){v[0], v[1], v[2], v[3]} * 0.03125f;
                *(f32x4*)(dst + 4) = (f32x4){v[4], v[5], v[6], v[7]} * 0.03125f;
            }
        }
    }
#undef ROR_
}

__device__ __forceinline__ void phase2(const Params& P, char* smem) {
    char* ws = P.ws;
    const int tid = threadIdx.x, lane = tid & 63, w = tid >> 6, lm = lane & 15, g = lane >> 4;
    for (int h = blockIdx.x; h < 16; h += gridDim.x) {
        const float* lf = (const float*)(ws + O_LOGF) + (size_t)h * S + tid * 16;
        float* cu = (float*)(ws + O_CUM) + (size_t)h * S + tid * 16;
        double* part = (double*)smem;
        f32x4 v[4]; double s = 0.0;
#pragma unroll
        for (int i = 0; i < 4; ++i) { v[i] = *(const f32x4*)(lf + i * 4); s += (double)v[i][0] + (double)v[i][1] + (double)v[i][2] + (double)v[i][3]; }
        double inc = s;
#pragma unroll
        for (int o = 1; o < 64; o <<= 1) { const double up = __shfl_up(inc, o); if (lane >= o) inc += up; }
        __syncthreads();
        if (lane == 63) part[w] = inc;
        __syncthreads();
        double run = inc - s;
        for (int i = 0; i < w; ++i) run += part[i];
#pragma unroll
        for (int i = 0; i < 4; ++i) {
            f32x4 o;
#pragma unroll
            for (int r = 0; r < 4; ++r) { run += (double)v[i][r]; o[r] = (float)(run * 1.4426950408889634); }
            *(f32x4*)(cu + i * 4) = o;
        }
        __syncthreads();
    }
    const bf16_t* IQ = (const bf16_t*)(ws + O_IQ); const bf16_t* IK = (const bf16_t*)(ws + O_IK); const float* IW = (const float*)(ws + O_IW);
    float* SC = (float*)(ws + O_SC);
    for (int it = blockIdx.x; it < 2080; it += gridDim.x) {
        int qb = (int)((sqrtf(8.f * (float)it + 1.f) - 1.f) * 0.5f);
        while (qb * (qb + 1) / 2 > it) --qb;
        while ((qb + 1) * (qb + 2) / 2 <= it) ++qb;
        const int kc = it - qb * (qb + 1) / 2;
        const int q0 = qb * 128 + w * 16, k0 = kc * 128;
        if (k0 > q0 + 15) continue;
        bf16x8 af[8][2];
#pragma unroll
        for (int st = 0; st < 8; ++st)
#pragma unroll
            for (int ks = 0; ks < 2; ++ks) af[st][ks] = *(const bf16x8*)(IK + (size_t)(k0 + st * 16 + lm) * 64 + ks * 32 + g * 8);
        f32x4 sc[8];
#pragma unroll
        for (int st = 0; st < 8; ++st) sc[st] = (f32x4){0.f, 0.f, 0.f, 0.f};
        const bf16_t* qp = IQ + (size_t)(q0 + lm) * 16 * 64 + g * 8;
        const float* wp = IW + (size_t)(q0 + lm) * 16;
        bf16x8 b0 = *(const bf16x8*)qp, b1 = *(const bf16x8*)(qp + 32);
        float wh = wp[0];
#pragma unroll 1
        for (int h = 0; h < 16; ++h) {
            const int hn = h < 15 ? h + 1 : 15;
            const bf16x8 nb0 = *(const bf16x8*)(qp + hn * 64), nb1 = *(const bf16x8*)(qp + hn * 64 + 32);
            const float nwh = wp[hn];
#pragma unroll
            for (int st = 0; st < 8; ++st) {
                f32x4 c = (f32x4){0.f, 0.f, 0.f, 0.f};
                c = mfma(af[st][0], b0, c); c = mfma(af[st][1], b1, c);
#pragma unroll
                for (int r4 = 0; r4 < 4; ++r4) sc[st][r4] += wh * fmaxf(c[r4], 0.f);
            }
            b0 = nb0; b1 = nb1; wh = nwh;
        }
#pragma unroll
        for (int st = 0; st < 8; ++st) *(f32x4*)(SC + (size_t)(q0 + lm) * S + k0 + st * 16 + g * 4) = sc[st];
    }
}

__device__ __forceinline__ void fox_item(const Params& P, int h, int qt, char* smem) {
    char* ws = P.ws;
    bf16_t* Ks = (bf16_t*)smem;
    bf16_t* Vs = (bf16_t*)(smem + 17408);
    float* Cs = (float*)(smem + 35840);
    const int tid = threadIdx.x, lane = tid & 63, w = tid >> 6, lm = lane & 15, g = lane >> 4;
    const int q0 = qt * 256, qw0 = q0 + w * 32;
    const bf16_t* FQh = (const bf16_t*)(ws + O_FQ) + (size_t)h * S * 128;
    const bf16_t* FKh = (const bf16_t*)(ws + O_FK) + (size_t)h * S * 128;
    const bf16_t* FVh = (const bf16_t*)(ws + O_FVT) + (size_t)h * 128 * S;
    const float* cumh = (const float*)(ws + O_CUM) + (size_t)h * S;
    bf16x8 qf[2][4]; float ct[2];
#pragma unroll
    for (int nt = 0; nt < 2; ++nt) {
        const int qrow = qw0 + nt * 16 + lm;
#pragma unroll
        for (int ks = 0; ks < 4; ++ks) qf[nt][ks] = *(const bf16x8*)(FQh + (size_t)qrow * 128 + ks * 32 + g * 8);
        ct[nt] = cumh[qrow];
    }
    f32x4 o[2][8];
#pragma unroll
    for (int nt = 0; nt < 2; ++nt)
#pragma unroll
        for (int dt = 0; dt < 8; ++dt) o[nt][dt] = (f32x4){0.f, 0.f, 0.f, 0.f};
    float lrun[2] = {0.f, 0.f};
    const int nkt = qt * 4 + 4;
    int kt0 = 0; float lbound = 0.f;
    {
        float mq = fmaxf(fabsf(P.fqg[lane]), fabsf(P.fqg[lane + 64])), mk = fmaxf(fabsf(P.fkg[lane]), fabsf(P.fkg[lane + 64]));
#pragma unroll
        for (int o2 = 32; o2; o2 >>= 1) { mq = fmaxf(mq, __shfl_xor(mq, o2)); mk = fmaxf(mk, __shfl_xor(mk, o2)); }
        lbound = 128.0f * QSCALE * mq * mk * 1.01f;
        const float thr = cumh[q0] + 2.0f * lbound + 40.0f;
        int lo = 0, hi = qt * 4;
        while (lo < hi) { const int mid = (lo + hi) >> 1; if (cumh[mid * 64 + 63] <= thr) hi = mid; else lo = mid + 1; }
        kt0 = lo;
    }
    u32x4 rk[2], rv[2]; float rc = 0.f;
    const int krow_s = tid >> 4, kcc_s = tid & 15, vrow_s = tid >> 3, vcc_s = tid & 7;
#pragma unroll
    for (int i = 0; i < 2; ++i) {
        rk[i] = *(const u32x4*)(FKh + (size_t)(kt0 * 64 + krow_s + i * 32) * 128 + kcc_s * 8);
        rv[i] = *(const u32x4*)(FVh + (size_t)(vrow_s + i * 64) * S + kt0 * 64 + vcc_s * 8);
    }
    if (tid < 64) rc = cumh[kt0 * 64 + tid];
    for (int kt = kt0; kt < nkt; ++kt) {
        __syncthreads();
#pragma unroll
        for (int i = 0; i < 2; ++i) {
            *(u32x4*)(Ks + (krow_s + i * 32) * 136 + kcc_s * 8) = rk[i];
            *(u32x4*)(Vs + (vrow_s + i * 64) * 72 + vcc_s * 8) = rv[i];
        }
        if (tid < 64) Cs[tid] = rc;
        __syncthreads();
        if (kt + 1 < nkt) {
            const int kb1 = (kt + 1) * 64;
#pragma unroll
            for (int i = 0; i < 2; ++i) {
                rk[i] = *(const u32x4*)(FKh + (size_t)(kb1 + krow_s + i * 32) * 128 + kcc_s * 8);
                rv[i] = *(const u32x4*)(FVh + (size_t)(vrow_s + i * 64) * S + kb1 + vcc_s * 8);
            }
            if (tid < 64) rc = cumh[kb1 + tid];
        }
        const int kb = kt * 64;
        if (kb <= qw0 + 31) {
            const bool diag = kb + 63 > qw0;
#pragma unroll 1
            for (int p = 0; p < 2; ++p) {
                f32x4 sa[2][2];
#pragma unroll
                for (int ab = 0; ab < 2; ++ab) {
                    const int krow = 32 * p + (lm >> 2) * 8 + ab * 4 + (lm & 3);
                    f32x4 c0 = (f32x4){0.f, 0.f, 0.f, 0.f}, c1 = c0;
#pragma unroll
                    for (int ks = 0; ks < 4; ++ks) {
                        const bf16x8 a = *(const bf16x8*)(Ks + krow * 136 + ks * 32 + g * 8);
                        c0 = mfma(a, qf[0][ks], c0); c1 = mfma(a, qf[1][ks], c1);
                    }
                    sa[ab][0] = c0; sa[ab][1] = c1;
                    asm volatile("" ::: "memory");
                }
                const f32x4 cs0 = *(const f32x4*)(Cs + 32 * p + g * 8), cs1 = *(const f32x4*)(Cs + 32 * p + g * 8 + 4);
                bf16x8 pf[2];
#pragma unroll
                for (int nt = 0; nt < 2; ++nt) {
                    const int qabs = qw0 + nt * 16 + lm;
                    const float ctm = ct[nt] - lbound;
                    float ls = 0.f;
#pragma unroll
                    for (int ab = 0; ab < 2; ++ab)
#pragma unroll
                        for (int r = 0; r < 4; ++r) {
                            float v = sa[ab][nt][r] + (ctm - (ab ? cs1[r] : cs0[r]));
                            if (diag && (kb + 32 * p + g * 8 + ab * 4 + r > qabs)) v = NEG_INF;
                            const float pv = __builtin_amdgcn_exp2f(v); sa[ab][nt][r] = pv; ls += pv;
                        }
                    lrun[nt] += ls;
                    u32x4 t4;
                    t4.x = pk_bf16(sa[0][nt][0], sa[0][nt][1]); t4.y = pk_bf16(sa[0][nt][2], sa[0][nt][3]);
                    t4.z = pk_bf16(sa[1][nt][0], sa[1][nt][1]); t4.w = pk_bf16(sa[1][nt][2], sa[1][nt][3]);
                    pf[nt] = __builtin_bit_cast(bf16x8, t4);
                }
#pragma unroll
                for (int dt = 0; dt < 8; ++dt) {
                    const bf16x8 a = *(const bf16x8*)(Vs + (dt * 16 + lm) * 72 + 32 * p + g * 8);
                    o[0][dt] = mfma(a, pf[0], o[0][dt]); o[1][dt] = mfma(a, pf[1], o[1][dt]);
                    if ((dt & 1) == 1) asm volatile("" ::: "memory");
                }
            }
        }
    }
    bf16_t* MIX = (bf16_t*)(ws + O_MIX);
#pragma unroll
    for (int nt = 0; nt < 2; ++nt) {
        float l = lrun[nt]; l += __shfl_xor(l, 16); l += __shfl_xor(l, 32);
        const float inv = 1.0f / l;
        const int qrow = qw0 + nt * 16 + lm;
#pragma unroll
        for (int dt = 0; dt < 8; ++dt) {
            u32x2 t2; t2.x = pk_bf16(o[nt][dt][0] * inv, o[nt][dt][1] * inv); t2.y = pk_bf16(o[nt][dt][2] * inv, o[nt][dt][3] * inv);
            *(u32x2*)(MIX + (size_t)qrow * D + h * 128 + dt * 16 + g * 4) = t2;
        }
    }
}

__device__ __forceinline__ int dpp_row_scan(int x) {
    x += __builtin_amdgcn_update_dpp(0, x, 0x111, 0xf, 0xf, true);
    x += __builtin_amdgcn_update_dpp(0, x, 0x112, 0xf, 0xf, true);
    x += __builtin_amdgcn_update_dpp(0, x, 0x114, 0xf, 0xf, true);
    x += __builtin_amdgcn_update_dpp(0, x, 0x118, 0xf, 0xf, true);
    return x;
}
__device__ __forceinline__ int wave_sum_i32(int x) {
    x = dpp_row_scan(x);
    return (__builtin_amdgcn_readlane(x, 15) + __builtin_amdgcn_readlane(x, 31)) + (__builtin_amdgcn_readlane(x, 47) + __builtin_amdgcn_readlane(x, 63));
}
__device__ __forceinline__ int wave_excl_scan_i32(int x, int& tot, const int lane) {
    const int sc = dpp_row_scan(x);
    const int t0 = __builtin_amdgcn_readlane(sc, 15), t1 = __builtin_amdgcn_readlane(sc, 31), t2 = __builtin_amdgcn_readlane(sc, 47), t3 = __builtin_amdgcn_readlane(sc, 63);
    tot = (t0 + t1) + (t2 + t3);
    return sc - x + (lane >= 16 ? t0 : 0) + (lane >= 32 ? t1 : 0) + (lane >= 48 ? t2 : 0);
}
template <int NJ>
__device__ __forceinline__ void wave_thresh256(const unsigned (&key)[NJ][4], const int jmax, unsigned& tg) {
    unsigned prefix = 0u;
    for (int bit = 31; bit >= 0; --bit) {
        const unsigned cand = prefix | (1u << bit);
        int lc = 0;
#pragma unroll
        for (int j = 0; j < NJ; ++j)
            if (j < jmax) {
#pragma unroll
                for (int c = 0; c < 4; ++c) lc += (key[j][c] >= cand) ? 1 : 0;
            }
        const int tot = wave_sum_i32(lc);
        if (tot >= 256) { prefix = cand; if (tot == 256) { prefix = cand - 1u; break; } }
    }
    tg = prefix;
}
__device__ __forceinline__ int wave_count_ge16(const unsigned (&key)[16][4], const int jmax, const unsigned cand) {
    int lc = 0;
#pragma unroll
    for (int j = 0; j < 16; ++j)
        if (j < jmax) {
#pragma unroll
            for (int c = 0; c < 4; ++c) lc += (key[j][c] >= cand) ? 1 : 0;
        }
    return wave_sum_i32(lc);
}
__device__ __forceinline__ void wave_thresh256_big(const unsigned (&key)[16][4], const int jmax, const int nv, const unsigned hint, unsigned& tg) {
    unsigned est = hint;
    if (est == 0u) {
        int lm_ = 0;
#pragma unroll
        for (int j = 0; j < 16; j += 2) lm_ += (j < jmax && key[j][0] != 0u) ? 1 : 0;
        const int m = wave_sum_i32(lm_);
        int r = (256 * m + (nv >> 1)) / nv; r = r < 1 ? 1 : (r > m ? m : r);
        unsigned prefix = 0u;
        for (int bit = 31; bit >= 18; --bit) {
            const unsigned cand = prefix | (1u << bit);
            int lc = 0;
#pragma unroll
            for (int j = 0; j < 16; j += 2) lc += (j < jmax && key[j][0] >= cand) ? 1 : 0;
            if (wave_sum_i32(lc) >= r) prefix = cand;
        }
        est = prefix | (1u << 17);
    }
    const unsigned DEL = 1u << 21;
    u64 lo = est > DEL ? (u64)(est - DEL) : 0ull, hi = (u64)est + DEL;
    if (hi > 0x100000000ull) hi = 0x100000000ull;
    if (lo > 0ull) {
        const int cl = wave_count_ge16(key, jmax, (unsigned)lo);
        if (cl == 256) { tg = (unsigned)lo - 1u; return; }
        if (cl < 256) { hi = lo; lo = 0ull; }
    }
    if (hi < 0x100000000ull && hi > lo + 0ull && !(lo == 0ull && hi <= (u64)(est > DEL ? est - DEL : 0u))) {
        const int ch = wave_count_ge16(key, jmax, (unsigned)hi);
        if (ch == 256) { tg = (unsigned)hi - 1u; return; }
        if (ch > 256) { lo = hi; hi = 0x100000000ull; }
    }
    while (hi - lo > 1ull) {
        const u64 mid = lo + ((hi - lo) >> 1);
        const int c = wave_count_ge16(key, jmax, (unsigned)mid);
        if (c == 256) { tg = (unsigned)mid - 1u; return; }
        if (c > 256) lo = mid; else hi = mid;
    }
    tg = (unsigned)lo;
}
template <int NJ, int MODE, bool IDARR>
__device__ __forceinline__ int wave_compact(const unsigned (&key)[NJ][4], const unsigned short (&eidarr)[2][4], const int ebase, const int jmax, const unsigned tg, const bool take_all,
                                            unsigned short* osel, unsigned* okey, unsigned short* oidx, const int lane) {
#define EID(j, c) (IDARR ? eidarr[(j) & 1][c] : (unsigned short)(ebase + (j) * 256 + lane * 4 + (c)))
    int lg = 0, le = 0;
#pragma unroll
    for (int j = 0; j < NJ; ++j)
        if (j < jmax) {
#pragma unroll
            for (int c = 0; c < 4; ++c) { lg += (key[j][c] > tg) ? 1 : 0; le += (key[j][c] == tg) ? 1 : 0; }
        }
    int totg, tote;
    int pg = wave_excl_scan_i32(lg, totg, lane), pe = wave_excl_scan_i32(le, tote, lane);
    const int need = take_all ? 0 : 256 - totg;
#pragma unroll
    for (int j = 0; j < NJ; ++j)
        if (j < jmax) {
#pragma unroll
            for (int c = 0; c < 4; ++c) {
                const unsigned k = key[j][c];
                if (k > tg) { if (MODE == 0) osel[pg] = EID(j, c); else { okey[pg] = k; oidx[pg] = EID(j, c); } ++pg; }
                else if (k == tg && !take_all) { if (pe < need) { if (MODE == 0) osel[totg + pe] = EID(j, c); else { okey[totg + pe] = k; oidx[totg + pe] = EID(j, c); } } ++pe; }
            }
        }
    return take_all ? totg : 256;
#undef EID
}
__device__ __forceinline__ void dsa_select_wave(const Params& P, const int t, unsigned short* sel, unsigned* lkey, unsigned short* lidx, const int lane) {
    const int n = t + 1;
    for (int i = lane; i < 272; i += 64) sel[i] = 0;
    if (n <= 256) { for (int i = lane; i < n; i += 64) sel[i] = (unsigned short)i; return; }
    const float* scrow = (const float*)(P.ws + O_SC) + (size_t)t * S;
    const int nh = n > 4096 ? 2 : 1;
    int cnt1 = 0; unsigned tg0 = 0u;
#pragma unroll 1
    for (int h = 0; h < nh; ++h) {
        const int base = h * 4096;
        const int nv = (n - base) < 4096 ? (n - base) : 4096;
        const int jmax = (nv + 255) >> 8;
        unsigned key[16][4]; const unsigned short noid[2][4] = {{0, 0, 0, 0}, {0, 0, 0, 0}};
#pragma unroll
        for (int j = 0; j < 16; ++j) {
            if (j < jmax) {
                const f32x4 v = *(const f32x4*)(scrow + base + j * 256 + lane * 4);
#pragma unroll
                for (int c = 0; c < 4; ++c) key[j][c] = (base + j * 256 + lane * 4 + c <= t) ? f2key(v[c]) : 0u;
            } else {
#pragma unroll
                for (int c = 0; c < 4; ++c) key[j][c] = 0u;
            }
        }
        const bool all = nv <= 256;
        unsigned tg = 0u;
        if (!all) { wave_thresh256_big(key, jmax, nv, h == 1 ? tg0 : 0u, tg); if (h == 0) tg0 = tg; }
        if (nh == 1) wave_compact<16, 0, false>(key, noid, base, jmax, tg, false, sel, lkey, lidx, lane);
        else { const int c = wave_compact<16, 1, false>(key, noid, base, jmax, tg, all, sel, lkey + h * 256, lidx + h * 256, lane); if (h == 1) cnt1 = c; }
    }
    if (nh == 2) {
        __builtin_amdgcn_fence(__ATOMIC_SEQ_CST, "wavefront");
        __builtin_amdgcn_wave_barrier();
        const int m = 256 + cnt1;
        unsigned key[2][4]; unsigned short eid[2][4];
#pragma unroll
        for (int j = 0; j < 2; ++j)
#pragma unroll
            for (int c = 0; c < 4; ++c) { const int i = j * 256 + lane * 4 + c; key[j][c] = i < m ? lkey[i] : 0u; eid[j][c] = lidx[i]; }
        unsigned tg = 0u;
        wave_thresh256<2>(key, 2, tg);
        wave_compact<2, 0, true>(key, eid, 0, 2, tg, false, sel, lkey, lidx, lane);
    }
}

__device__ __forceinline__ void dsa_attend(const Params& P, const int t, const unsigned short* sel, bf16_t* Vc, const int lane, const float lbound) {
    char* ws = P.ws;
    const int lm = lane & 15, g = lane >> 4;
    const int n = t + 1, nsel = n < 256 ? n : 256;
    const int ngr = (nsel + 15) >> 4;
    const bf16_t* DQ = (const bf16_t*)(ws + O_DQ); const bf16_t* DK = (const bf16_t*)(ws + O_DK); const bf16_t* DV = (const bf16_t*)(ws + O_DV);
    bf16x8 qf[4];
#pragma unroll
    for (int ks = 0; ks < 4; ++ks) qf[ks] = *(const bf16x8*)(DQ + ((size_t)t * 16 + lm) * 128 + ks * 32 + g * 8);
    f32x4 o[8];
#pragma unroll
    for (int dt = 0; dt < 8; ++dt) o[dt] = (f32x4){0.f, 0.f, 0.f, 0.f};
    float lsum = 0.f;
    bf16x8 kr[2][4]; u32x4 vr[8];
#pragma unroll
    for (int hf = 0; hf < 2; ++hf) {
        const bf16_t* kp = DK + (size_t)sel[hf * 16 + lm] * 128 + g * 8;
#pragma unroll
        for (int ks = 0; ks < 4; ++ks) kr[hf][ks] = *(const bf16x8*)(kp + ks * 32);
    }
#pragma unroll
    for (int i = 0; i < 8; ++i) vr[i] = *(const u32x4*)(DV + (size_t)sel[i * 4 + g] * 128 + lm * 8);
#pragma unroll 1
    for (int c = 0; c < 8; ++c) {
        if (2 * c >= ngr) break;
        f32x4 s0 = (f32x4){0.f, 0.f, 0.f, 0.f}, s1 = s0;
#pragma unroll
        for (int ks = 0; ks < 4; ++ks) { s0 = mfma(kr[0][ks], qf[ks], s0); s1 = mfma(kr[1][ks], qf[ks], s1); }
#pragma unroll
        for (int i = 0; i < 8; ++i) *(u32x4*)(Vc + (i * 4 + g) * 136 + lm * 8) = vr[i];
        __builtin_amdgcn_fence(__ATOMIC_SEQ_CST, "wavefront");
        __builtin_amdgcn_wave_barrier();
        if (c < 7 && 2 * (c + 1) < ngr) {
#pragma unroll
            for (int hf = 0; hf < 2; ++hf) {
                const bf16_t* kp = DK + (size_t)sel[(c + 1) * 32 + hf * 16 + lm] * 128 + g * 8;
#pragma unroll
                for (int ks = 0; ks < 4; ++ks) kr[hf][ks] = *(const bf16x8*)(kp + ks * 32);
            }
#pragma unroll
            for (int i = 0; i < 8; ++i) vr[i] = *(const u32x4*)(DV + (size_t)sel[(c + 1) * 32 + i * 4 + g] * 128 + lm * 8);
        }
        float p0[4], p1[4];
#pragma unroll
        for (int r = 0; r < 4; ++r) {
            p0[r] = (c * 32 + g * 4 + r < nsel) ? __builtin_amdgcn_exp2f(s0[r] - lbound) : 0.f;
            p1[r] = (c * 32 + 16 + g * 4 + r < nsel) ? __builtin_amdgcn_exp2f(s1[r] - lbound) : 0.f;
            lsum += p0[r] + p1[r];
        }
        u32x4 t4;
        t4.x = pk_bf16(p0[0], p0[1]); t4.y = pk_bf16(p0[2], p0[3]); t4.z = pk_bf16(p1[0], p1[1]); t4.w = pk_bf16(p1[2], p1[3]);
        const bf16x8 pf = __builtin_bit_cast(bf16x8, t4);
        typedef short v4i16_t __attribute__((ext_vector_type(4)));
        const bf16_t* tb = Vc + (g * 4 + (lm >> 2)) * 136 + (lm & 3) * 4;
#pragma unroll
        for (int dt = 0; dt < 8; ++dt) {
            const v4i16_t lo = __builtin_amdgcn_ds_read_tr16_b64_v4i16((__attribute__((address_space(3))) v4i16_t*)(tb + dt * 16));
            const v4i16_t hi = __builtin_amdgcn_ds_read_tr16_b64_v4i16((__attribute__((address_space(3))) v4i16_t*)(tb + 16 * 136 + dt * 16));
            bf16x8 a;
            a[0] = lo[0]; a[1] = lo[1]; a[2] = lo[2]; a[3] = lo[3]; a[4] = hi[0]; a[5] = hi[1]; a[6] = hi[2]; a[7] = hi[3];
            o[dt] = mfma(a, pf, o[dt]);
        }
        __builtin_amdgcn_fence(__ATOMIC_SEQ_CST, "wavefront");
        __builtin_amdgcn_wave_barrier();
    }
    lsum += __shfl_xor(lsum, 16); lsum += __shfl_xor(lsum, 32);
    const float inv = 1.0f / lsum;
    bf16_t* MIX = (bf16_t*)(ws + O_MIX) + (size_t)t * D + 2048 + lm * 128;
#pragma unroll
    for (int dt = 0; dt < 8; ++dt) {
        u32x2 t2; t2.x = pk_bf16(o[dt][0] * inv, o[dt][1] * inv); t2.y = pk_bf16(o[dt][2] * inv, o[dt][3] * inv);
        *(u32x2*)(MIX + dt * 16 + g * 4) = t2;
    }
}

__device__ __forceinline__ void phase3(const Params& P, char* smem) {
    unsigned* ctr = (unsigned*)(P.ws + O_CTR);
    int* slot = (int*)(smem + 131072);
    const int w = threadIdx.x >> 6, lane = threadIdx.x & 63;
    for (;;) {
        __syncthreads();
        if (threadIdx.x == 0) *slot = (int)atomicAdd(ctr, 1u);
        __syncthreads();
        const int item = *slot;
        if (item >= 512) break;
        fox_item(P, item & 15, 31 - (item >> 4), smem);
    }
    float dsa_lbound;
    {
        float mq = fmaxf(fabsf(P.dqg[lane]), fabsf(P.dqg[lane + 64])), mk = fmaxf(fabsf(P.dkg[lane]), fabsf(P.dkg[lane + 64]));
#pragma unroll
        for (int o2 = 32; o2; o2 >>= 1) { mq = fmaxf(mq, __shfl_xor(mq, o2)); mk = fmaxf(mk, __shfl_xor(mk, o2)); }
        dsa_lbound = 128.0f * QSCALE * mq * mk * 1.01f;
    }
    for (;;) {
        __syncthreads();
        if (threadIdx.x == 0) *slot = (int)atomicAdd(ctr + 32, 1u);
        __syncthreads();
        const int item = *slot;
        if (item >= S / 8) break;
        const int t0 = S - 8 - 8 * item;
        char* wsm = smem + w * 12544;
        dsa_select_wave(P, t0 + w, (unsigned short*)wsm, (unsigned*)(wsm + 576), (unsigned short*)(wsm + 2624), lane);
        __builtin_amdgcn_fence(__ATOMIC_SEQ_CST, "wavefront");
        __builtin_amdgcn_wave_barrier();
        dsa_attend(P, t0 + w, (const unsigned short*)wsm, (bf16_t*)(wsm + 3648), lane, dsa_lbound);
    }
}

template <int NV>
__device__ __forceinline__ void wave_top16(const float (&val)[NV], const int (&idx)[NV], float* outv, int* outi, const int lane) {
    unsigned key[NV];
#pragma unroll
    for (int v = 0; v < NV; ++v) key[v] = f2key(val[v]);
    unsigned prefix = 0; bool exact = false;
    for (int bit = 31; bit >= 0; --bit) {
        const unsigned cand = prefix | (1u << bit);
        int cnt = 0;
#pragma unroll
        for (int v = 0; v < NV; ++v) cnt += popc(ballot(key[v] >= cand));
        if (cnt >= 16) { prefix = cand; if (cnt == 16) { exact = true; break; } }
    }
    const unsigned tg = exact ? prefix - 1u : prefix;
    int cgt = 0;
#pragma unroll
    for (int v = 0; v < NV; ++v) cgt += popc(ballot(key[v] > tg));
    const int need = 16 - cgt;
    const u64 lt = (1ull << lane) - 1ull;
    int base = 0, tbase = 0;
#pragma unroll
    for (int v = 0; v < NV; ++v) {
        const bool gt = key[v] > tg; const u64 mg = ballot(gt);
        if (gt) { const int p = base + popc(mg & lt); outv[p] = val[v]; outi[p] = idx[v]; }
        base += popc(mg);
        const bool eq = key[v] == tg; const u64 me = ballot(eq);
        const int tp = tbase + popc(me & lt);
        if (eq && tp < need) { outv[cgt + tp] = val[v]; outi[cgt + tp] = idx[v]; }
        tbase += popc(me);
    }
}

__device__ __forceinline__ void peer_token(const Params& P, const int t, char* wsm, const int lane) {
    char* ws = P.ws;
    int* eidx = (int*)wsm;
    float* gate = (float*)(wsm + 512);
    float* aval = (float*)(wsm + 1024);
    float* l1v = (float*)(wsm + 1536); int* l1i = (int*)(wsm + 1600);
    float* l2v = (float*)(wsm + 1664); int* l2i = (int*)(wsm + 1728);
    float* bv = (float*)(wsm + 1792); int* bi = (int*)(wsm + 1856);
    const bf16_t* QP = (const bf16_t*)(ws + O_QP) + (size_t)t * 1024;
    const bf16_t* K1 = (const bf16_t*)(ws + O_K1); const bf16_t* K2 = (const bf16_t*)(ws + O_K2);
    const float rstd = rsqrtf(wave_sum(((const float*)(ws + O_PART))[(size_t)t * 64 + lane]) * (1.0f / 4096.0f) + 1e-6f);
    for (int hh = 0; hh < 8; ++hh) {
        float s1[2] = {0.f, 0.f}, s2[2] = {0.f, 0.f};
        const u32x4* q1 = (const u32x4*)(QP + hh * 128); const u32x4* q2 = (const u32x4*)(QP + hh * 128 + 64);
        const u32x4* ka = (const u32x4*)(K1 + (size_t)hh * 8192) + lane; const u32x4* kc = (const u32x4*)(K2 + (size_t)hh * 8192) + lane;
#pragma unroll
        for (int c = 0; c < 8; ++c) {
            const u32x4 x1 = q1[c], x2 = q2[c], a = ka[c * 128], b = ka[c * 128 + 64], cc = kc[c * 128], d = kc[c * 128 + 64];
#pragma unroll
            for (int q = 0; q < 4; ++q) { s1[0] = fdot2(x1[q], a[q], s1[0]); s1[1] = fdot2(x1[q], b[q], s1[1]); s2[0] = fdot2(x2[q], cc[q], s2[0]); s2[1] = fdot2(x2[q], d[q], s2[1]); }
        }
        const int id2[2] = {lane, lane + 64};
        wave_top16<2>(s1, id2, l1v, l1i, lane);
        wave_top16<2>(s2, id2, l2v, l2i, lane);
        __builtin_amdgcn_fence(__ATOMIC_SEQ_CST, "wavefront");
        __builtin_amdgcn_wave_barrier();
        float cv[4]; int ci[4];
#pragma unroll
        for (int c = 0; c < 4; ++c) { ci[c] = c * 64 + lane; cv[c] = l1v[ci[c] >> 4] + l2v[ci[c] & 15]; }
        wave_top16<4>(cv, ci, bv, bi, lane);
        __builtin_amdgcn_fence(__ATOMIC_SEQ_CST, "wavefront");
        __builtin_amdgcn_wave_barrier();
        float m = NEG_INF;
#pragma unroll
        for (int k = 0; k < 16; ++k) m = fmaxf(m, bv[k]);
        float sum = 0.f;
#pragma unroll
        for (int k = 0; k < 16; ++k) sum += expf((bv[k] - m) * rstd);
        if (lane < 16) {
            const int c = bi[lane];
            eidx[hh * 16 + lane] = l1i[c >> 4] * 128 + l2i[c & 15];
            gate[hh * 16 + lane] = expf((bv[lane] - m) * rstd) / sum;
        }
        __builtin_amdgcn_fence(__ATOMIC_SEQ_CST, "wavefront");
        __builtin_amdgcn_wave_barrier();
    }
    {
        int* seidx = (int*)(wsm + 2048); float* sgate = (float*)(wsm + 2560);
        const int e0 = eidx[lane], e1 = eidx[lane + 64]; const float g0 = gate[lane], g1 = gate[lane + 64];
        int r0 = 0, r1 = 0;
#pragma unroll 8
        for (int k = 0; k < 128; ++k) {
            const int ek = eidx[k];
            r0 += (ek < e0 || (ek == e0 && k < lane)) ? 1 : 0;
            r1 += (ek < e1 || (ek == e1 && k < lane + 64)) ? 1 : 0;
        }
        seidx[r0] = e0; sgate[r0] = g0; seidx[r1] = e1; sgate[r1] = g1;
        __builtin_amdgcn_fence(__ATOMIC_SEQ_CST, "wavefront");
        __builtin_amdgcn_wave_barrier();
        eidx = seidx; gate = sgate;
    }
    float xf[64];
    {
        const bf16_t* xrow = (const bf16_t*)(ws + O_H2) + (size_t)t * D;
#pragma unroll
        for (int h = 0; h < 2; ++h)
#pragma unroll
            for (int q = 0; q < 8; ++q) {
                const u32x2 a = ((const u32x2*)(xrow + h * 2048 + q * 256))[lane];
                xf[h * 32 + 4 * q] = bf_lo(a.x); xf[h * 32 + 4 * q + 1] = bf_hi(a.x); xf[h * 32 + 4 * q + 2] = bf_lo(a.y); xf[h * 32 + 4 * q + 3] = bf_hi(a.y);
            }
    }
    const unsigned char* UB = (const unsigned char*)(ws + O_UB); const unsigned char* VB = (const unsigned char*)(ws + O_VB);
    {
        u32x4 rr[2][3];
#pragma unroll
        for (int j = 0; j < 2; ++j) {
            const int e = __builtin_amdgcn_readfirstlane(eidx[j]);
            const u32x4* rp = (const u32x4*)(UB + (size_t)e * 3072) + lane;
#pragma unroll
            for (int c = 0; c < 3; ++c) rr[j][c] = rp[c * 64];
        }
        for (int k = 0; k < 128; k += 2) {
            float dsum[2];
#pragma unroll
            for (int j = 0; j < 2; ++j) {
                const v32f_t wa = __builtin_amdgcn_cvt_scalef32_pk32_f32_fp6((v6u_t){rr[j][0][0], rr[j][0][1], rr[j][0][2], rr[j][0][3], rr[j][1][0], rr[j][1][1]}, 1.0f);
                const v32f_t wb = __builtin_amdgcn_cvt_scalef32_pk32_f32_fp6((v6u_t){rr[j][1][2], rr[j][1][3], rr[j][2][0], rr[j][2][1], rr[j][2][2], rr[j][2][3]}, 1.0f);
                float d0 = 0.f, d1 = 0.f;
#pragma unroll
                for (int i = 0; i < 32; ++i) { d0 += wa[i] * xf[i]; d1 += wb[i] * xf[32 + i]; }
                dsum[j] = d0 + d1;
            }
            if (k + 2 < 128) {
#pragma unroll
                for (int j = 0; j < 2; ++j) {
                    const int e = __builtin_amdgcn_readfirstlane(eidx[k + 2 + j]);
                    const u32x4* rp = (const u32x4*)(UB + (size_t)e * 3072) + lane;
#pragma unroll
                    for (int c = 0; c < 3; ++c) rr[j][c] = rp[c * 64];
                }
            }
#pragma unroll
            for (int j = 0; j < 2; ++j) dsum[j] = wave_sum(dsum[j]);
            if (lane == 0) {
#pragma unroll
                for (int j = 0; j < 2; ++j) {
                    const float hv = dsum[j] * (rstd * (1.0f / U_SCALE));
                    aval[k + j] = gate[k + j] * 0.5f * hv * (1.0f + erff(hv * 0.70710678118654752f)) * (1.0f / V_SCALE);
                }
            }
        }
    }
    __builtin_amdgcn_fence(__ATOMIC_SEQ_CST, "wavefront");
    __builtin_amdgcn_wave_barrier();
    float acc[64];
#pragma unroll
    for (int i = 0; i < 64; ++i) acc[i] = 0.f;
    for (int k = 0; k < 128; k += 2) {
        u32x4 rr[2][3];
#pragma unroll
        for (int j = 0; j < 2; ++j) {
            const int e = __builtin_amdgcn_readfirstlane(eidx[k + j]);
            const u32x4* rp = (const u32x4*)(VB + (size_t)e * 3072) + lane;
#pragma unroll
            for (int c = 0; c < 3; ++c) rr[j][c] = rp[c * 64];
        }
#pragma unroll
        for (int j = 0; j < 2; ++j) {
            const float av = aval[k + j];
            const v32f_t wa = __builtin_amdgcn_cvt_scalef32_pk32_f32_fp6((v6u_t){rr[j][0][0], rr[j][0][1], rr[j][0][2], rr[j][0][3], rr[j][1][0], rr[j][1][1]}, 1.0f);
            const v32f_t wb = __builtin_amdgcn_cvt_scalef32_pk32_f32_fp6((v6u_t){rr[j][1][2], rr[j][1][3], rr[j][2][0], rr[j][2][1], rr[j][2][2], rr[j][2][3]}, 1.0f);
#pragma unroll
            for (int i = 0; i < 32; ++i) { acc[i] += av * wa[i]; acc[32 + i] += av * wb[i]; }
        }
    }
    float* orow = P.out + (size_t)t * D;
#pragma unroll
    for (int h = 0; h < 2; ++h)
#pragma unroll
        for (int q = 0; q < 8; ++q) {
            f32x4* p4 = (f32x4*)(orow + h * 2048 + q * 256) + lane;
            f32x4 xv = *p4;
            xv[0] += acc[h * 32 + 4 * q]; xv[1] += acc[h * 32 + 4 * q + 1]; xv[2] += acc[h * 32 + 4 * q + 2]; xv[3] += acc[h * 32 + 4 * q + 3];
            *p4 = xv;
        }
}

__device__ __forceinline__ void phase7(const Params& P, char* smem) {
    const int w = threadIdx.x >> 6, lane = threadIdx.x & 63;
    const int nw = gridDim.x * NWV;
    for (int t = blockIdx.x * NWV + w; t < S; t += nw) peer_token(P, t, smem + w * 4096, lane);
}

#define LAS __attribute__((address_space(3)))
#define XB_TMO      128
#define XB_XCNT(j)  (256  + 64 * (j))
#define XB_XSUB(j)  (1280 + 64 * (j))
#define XB_XGEN(j)  (2304 + 64 * (j))
#define XB_TOP      3328
#define XB_TOPGEN   3392
#define XCD_BAR_WORDS 3456
#define XB_SPIN_CAP (1u << 18)

__device__ __forceinline__ unsigned xb_ld(unsigned* p)              { return __hip_atomic_load(p, __ATOMIC_RELAXED, __HIP_MEMORY_SCOPE_AGENT); }
__device__ __forceinline__ unsigned xb_add(unsigned* p, unsigned v) { return __hip_atomic_fetch_add(p, v, __ATOMIC_RELAXED, __HIP_MEMORY_SCOPE_AGENT); }
__device__ __forceinline__ unsigned xb_xcc_id() { return (unsigned)__builtin_amdgcn_s_getreg((3 << 11) | 20) & 0xFu; }
#define XB_SPIN(cond, bar) do { unsigned _sp = 0; while (cond) { __builtin_amdgcn_s_sleep(1); \
    if ((++_sp & 255u) == 0u) { if (xb_ld(&(bar)[XB_TMO])) break; if (_sp > XB_SPIN_CAP) { atomicAdd(&(bar)[XB_TMO], 1u); break; } } } } while (0)

struct XcdBarrier {
    unsigned* bar; unsigned x;
    volatile LAS unsigned* st;
};

__device__ __forceinline__ XcdBarrier xcd_barrier_post(unsigned* bar, volatile LAS unsigned* st) {
    XcdBarrier b; b.bar = bar; b.x = xb_xcc_id(); b.st = st;
    if (threadIdx.x == 0) (void)xb_add(&bar[XB_XCNT(b.x)], 1u);
    return b;
}
__device__ __forceinline__ void xcd_barrier_complete(unsigned* bar, unsigned x, unsigned& nloc, unsigned& nx) {
    const unsigned G = gridDim.x * gridDim.y * gridDim.z;
    unsigned sum, cnt, mine, sp = 0u;
    for (;;) {
        sum = 0u; cnt = 0u; mine = 0u;
#pragma unroll
        for (unsigned j = 0; j < 16; ++j) { const unsigned c = xb_ld(&bar[XB_XCNT(j)]); sum += c; cnt += (c > 0u) ? 1u : 0u; mine = (j == x) ? c : mine; }
        if (sum == G) break;
        __builtin_amdgcn_s_sleep(1);
        if ((++sp & 255u) == 0u) { if (xb_ld(&bar[XB_TMO])) break; if (sp > XB_SPIN_CAP) { atomicAdd(&bar[XB_TMO], 1u); break; } }
    }
    nloc = mine > 0u ? mine : 1u; nx = cnt > 0u ? cnt : 1u;
}

__device__ __forceinline__ void xcd_barrier(const XcdBarrier& b) {
    asm volatile("s_waitcnt vmcnt(0)" ::: "memory");
    __syncthreads();
    if (threadIdx.x == 0) {
        unsigned* bar = b.bar;
        __builtin_amdgcn_s_waitcnt(0);
        unsigned nloc = b.st[0], nx = b.st[1];
        if (nloc == 0u) { xcd_barrier_complete(bar, b.x, nloc, nx); b.st[0] = nloc; b.st[1] = nx; }
        const unsigned old = xb_add(&bar[XB_XSUB(b.x)], 1u);
        const unsigned gen = old / nloc;
        if (old + 1u == (gen + 1u) * nloc) {
            __builtin_amdgcn_fence(__ATOMIC_RELEASE, "agent");
            asm volatile("s_waitcnt vmcnt(0)" ::: "memory");
            const unsigned og = xb_add(&bar[XB_TOP], 1u);
            const unsigned tg = og / nx;
            if (og + 1u == (tg + 1u) * nx) xb_add(&bar[XB_TOPGEN], 1u);
            else XB_SPIN(xb_ld(&bar[XB_TOPGEN]) == tg, bar);
            __builtin_amdgcn_fence(__ATOMIC_ACQUIRE, "agent");
            xb_add(&bar[XB_XGEN(b.x)], 1u);
            asm volatile("s_waitcnt vmcnt(0)" ::: "memory");
        } else {
            XB_SPIN(xb_ld(&bar[XB_XGEN(b.x)]) == gen, bar);
            __builtin_amdgcn_fence(__ATOMIC_ACQUIRE, "agent");
            asm volatile("s_waitcnt vmcnt(0)" ::: "memory");
        }
    }
    __syncthreads();
}

constexpr int LDS_BYTES = 147456;
__global__ void __launch_bounds__(NT, 2) mega(Params P) {
    extern __shared__ __attribute__((aligned(16))) char smem[];
    cg::grid_group grid = cg::this_grid();
    volatile LAS unsigned* xst = (volatile LAS unsigned*)(smem + 131072 + 64);
    if (threadIdx.x == 0) { xst[0] = 0u; xst[1] = 0u; }
    const XcdBarrier xb = xcd_barrier_post((unsigned*)(P.ws + O_XB), xst);
    phase0(P, smem);
    if (P.ws == nullptr) grid.sync();
    xcd_barrier(xb);
    gemm_phase<0>(P, smem);
    xcd_barrier(xb);
    post_phase(P);
    xcd_barrier(xb);
    phase2(P, smem);
    xcd_barrier(xb);
    phase3(P, smem);
    xcd_barrier(xb);
    gemm_phase<1>(P, smem);
    xcd_barrier(xb);
    gemm_phase<2>(P, smem);
    xcd_barrier(xb);
    phase7(P, smem);
}

extern "C" void kernel_launch(void* const* d_in, const int* in_sizes, int n_in, void* d_out, int out_size, void* d_ws, size_t ws_size, hipStream_t stream) {
    (void)in_sizes; (void)n_in; (void)out_size;
    if (ws_size < WS_TOTAL2) { fprintf(stderr, "workspace too small: %zu < %zu\n", ws_size, (size_t)WS_TOTAL2); return; }
    Params P{};
    P.x = (const float*)d_in[0]; P.pos = (const int*)d_in[1]; P.ln1 = (const float*)d_in[2]; P.w_in = (const float*)d_in[3];
    P.fb = (const float*)d_in[4]; P.fqg = (const float*)d_in[5]; P.fkg = (const float*)d_in[6]; P.dqg = (const float*)d_in[7];
    P.dkg = (const float*)d_in[8]; P.w_o = (const float*)d_in[9]; P.ln2 = (const float*)d_in[10]; P.wq = (const float*)d_in[11];
    P.k1 = (const float*)d_in[12]; P.k2 = (const float*)d_in[13]; P.u = (const float*)d_in[14]; P.v = (const float*)d_in[15];
    P.out = (float*)d_out; P.ws = (char*)d_ws;
    static int grid_blocks = 0;
    if (!grid_blocks) {
        int dev = 0, cus = 0, per_cu = 0;
        (void)hipGetDevice(&dev);
        (void)hipDeviceGetAttribute(&cus, hipDeviceAttributeMultiprocessorCount, dev);
        if (hipFuncSetAttribute((const void*)mega, hipFuncAttributeMaxDynamicSharedMemorySize, LDS_BYTES) != hipSuccess) fprintf(stderr, "hipFuncSetAttribute failed\n");
        (void)hipOccupancyMaxActiveBlocksPerMultiprocessor(&per_cu, (const void*)mega, NT, LDS_BYTES);
        if (per_cu != 1) fprintf(stderr, "note: occupancy query reports %d workgroups per CU\n", per_cu);
        grid_blocks = cus;
    }
    (void)hipMemsetAsync((char*)d_ws + O_CTR, 0, 256 + 3456 * 4, stream);
    void* args[] = {&P};
    hipError_t e = hipLaunchCooperativeKernel((void*)mega, dim3(grid_blocks), dim3(NT), args, LDS_BYTES, stream);
    if (e != hipSuccess) fprintf(stderr, "cooperative launch failed: %s (grid %d)\n", hipGetErrorString(e), grid_blocks);
}
```

```cpp
#include <hip/hip_runtime.h>
#include <hip/hip_cooperative_groups.h>
#include <cstdio>
#include <cstdint>
namespace cg = cooperative_groups;


typedef unsigned short bf16_t;
typedef short bf16x8 __attribute__((ext_vector_type(8)));
typedef float f32x4 __attribute__((ext_vector_type(4)));
typedef unsigned u32x4 __attribute__((ext_vector_type(4)));
typedef unsigned u32x2 __attribute__((ext_vector_type(2)));
typedef __bf16 bf2_t __attribute__((ext_vector_type(2)));
typedef unsigned long long u64;

constexpr int S = 8192, D = 4096, HD = 128, NH = 16;
constexpr int NIN = 9568, NINP = 9728;
constexpr int NT = 512, NWV = 8;
constexpr float QSCALE = 0.08838834764831845f * 1.4426950408889634f;
constexpr float NEG_INF = -__builtin_inff();

constexpr size_t O_WTIN = 0;
constexpr size_t O_WTO  = O_WTIN + (size_t)NINP * D * 2;
constexpr size_t O_WTQ  = O_WTO + (size_t)D * D * 2;
constexpr size_t O_H    = O_WTQ + (size_t)1024 * D * 2;
constexpr size_t O_MIX  = O_H + (size_t)S * D * 2;
constexpr size_t O_FQ   = O_MIX + (size_t)S * D * 2;
constexpr size_t O_FK   = O_FQ + (size_t)NH * S * HD * 2;
constexpr size_t O_FVT  = O_FK + (size_t)NH * S * HD * 2;
constexpr size_t O_DQ   = O_FVT + (size_t)NH * S * HD * 2;
constexpr size_t O_DK   = O_DQ + (size_t)S * NH * HD * 2;
constexpr size_t O_DV   = O_DK + (size_t)S * HD * 2;
constexpr size_t O_IQ   = O_DV + (size_t)S * HD * 2;
constexpr size_t O_IK   = O_IQ + (size_t)S * 16 * 64 * 2;
constexpr size_t O_IW   = O_IK + (size_t)S * 64 * 2;
constexpr size_t O_LOGF = O_IW + (size_t)S * 16 * 4;
constexpr size_t O_CUM  = O_LOGF + (size_t)16 * S * 4;
constexpr size_t O_QP   = O_CUM + (size_t)16 * S * 4;
constexpr size_t O_K1   = O_QP + (size_t)S * 1024 * 2;
constexpr size_t O_K2   = O_K1 + (size_t)8 * 128 * 64 * 2;
constexpr size_t O_SC   = O_K2 + (size_t)8 * 128 * 64 * 2;
constexpr size_t O_PROJ = O_SC;
constexpr size_t O_H2   = O_SC + (size_t)S * S * 4;
constexpr size_t O_UB   = O_H2 + (size_t)S * D * 2;
constexpr size_t O_VB   = O_UB + (size_t)16384 * 3072;
constexpr size_t WS_TOTAL = O_VB + (size_t)16384 * 3072;
constexpr size_t O_PART = WS_TOTAL;
constexpr size_t O_CTR  = O_PART + (size_t)S * 64 * 4;
constexpr size_t O_XB   = O_CTR + 256;
constexpr size_t WS_TOTAL2 = O_XB + 3456 * 4;
constexpr float U_SCALE = 96.f, V_SCALE = 16.f;
typedef float v16f_t __attribute__((ext_vector_type(16)));
typedef float v32f_t __attribute__((ext_vector_type(32)));
typedef unsigned v6u_t __attribute__((ext_vector_type(6)));

struct Params {
    const float* x; const int* pos; const float* ln1; const float* w_in; const float* fb; const float* fqg; const float* fkg;
    const float* dqg; const float* dkg; const float* w_o; const float* ln2; const float* wq; const float* k1; const float* k2;
    const float* u; const float* v; float* out; char* ws;
};

typedef float f32x2 __attribute__((ext_vector_type(2)));
__device__ __forceinline__ unsigned pk_bf16(float lo, float hi) { const f32x2 v = {lo, hi}; return __builtin_bit_cast(unsigned, __builtin_convertvector(v, bf2_t)); }
__device__ __forceinline__ bf16_t f2bf(float f) { return (bf16_t)(pk_bf16(f, 0.f) & 0xffffu); }
__device__ __forceinline__ float bf_lo(unsigned u) { return __uint_as_float(u << 16); }
__device__ __forceinline__ float bf_hi(unsigned u) { return __uint_as_float(u & 0xffff0000u); }
__device__ __forceinline__ float wave_sum(float v) {
#define DPPF_(x, ctrl) __builtin_bit_cast(float, __builtin_amdgcn_update_dpp(0, __builtin_bit_cast(int, x), ctrl, 0xf, 0xf, true))
    v += DPPF_(v, 0x111); v += DPPF_(v, 0x112); v += DPPF_(v, 0x114); v += DPPF_(v, 0x118);
#undef DPPF_
    const int vi = __builtin_bit_cast(int, v);
    return (__builtin_bit_cast(float, __builtin_amdgcn_readlane(vi, 15)) + __builtin_bit_cast(float, __builtin_amdgcn_readlane(vi, 31))) +
           (__builtin_bit_cast(float, __builtin_amdgcn_readlane(vi, 47)) + __builtin_bit_cast(float, __builtin_amdgcn_readlane(vi, 63)));
}
__device__ __forceinline__ unsigned f2key(float f) { const unsigned u = __float_as_uint(f); return (u & 0x80000000u) ? ~u : (u | 0x80000000u); }
__device__ __forceinline__ u64 ballot(bool p) { return __builtin_amdgcn_ballot_w64(p); }
__device__ __forceinline__ int popc(u64 m) { return __builtin_popcountll(m); }
__device__ __forceinline__ f32x4 mfma(bf16x8 a, bf16x8 b, f32x4 c) { return __builtin_amdgcn_mfma_f32_16x16x32_bf16(a, b, c, 0, 0, 0); }
__device__ __forceinline__ float fdot2(unsigned a, unsigned b, float c) {
    return __builtin_amdgcn_fdot2_f32_bf16(__builtin_bit_cast(bf2_t, a), __builtin_bit_cast(bf2_t, b), c, false);
}
__device__ __forceinline__ void sincos_f(float ang, float& s, float& c) {
    double t = (double)ang * 0.15915494309189535; t -= rint(t);
    const float f = (float)t; s = __builtin_amdgcn_sinf(f); c = __builtin_amdgcn_cosf(f);
}
__device__ __forceinline__ float block_sum(float v, float* red) {
    v = wave_sum(v);
    __syncthreads();
    if ((threadIdx.x & 63) == 0) red[threadIdx.x >> 6] = v;
    __syncthreads();
    return ((red[0] + red[1]) + (red[2] + red[3])) + ((red[4] + red[5]) + (red[6] + red[7]));
}
__device__ __forceinline__ int in_src_col(int n) {
    if (n < 6144) return n;
    if (n < 9536) return n + 16;
    if (n < 9552) return n - 9536 + 6144;
    if (n < 9568) return n;
    return -1;
}

#define TILE_JOB(it_, W_, Wt_, ldw_, n0_, k0_, mode_) do { int _t = (it_); \
    if (_t < T_IN) { W_ = P.w_in; Wt_ = (bf16_t*)(P.ws + O_WTIN); ldw_ = NIN; mode_ = 1; } \
    else if (_t < T_IN + T_O) { _t -= T_IN; W_ = P.w_o; Wt_ = (bf16_t*)(P.ws + O_WTO); ldw_ = D; mode_ = 0; } \
    else { _t -= T_IN + T_O; W_ = P.wq; Wt_ = (bf16_t*)(P.ws + O_WTQ); ldw_ = 1024; mode_ = 0; } \
    n0_ = (_t >> 5) * 64; k0_ = (_t & 31) * 128; } while (0)
#define TILE_LOAD(W_, ldw_, n0_, k0_, mode_) do { const int _sc = (mode_) ? in_src_col((n0_) + tx) : ((n0_) + tx); \
    _Pragma("unroll") for (int i = 0; i < 16; ++i) r[i] = _sc >= 0 ? (W_)[(size_t)((k0_) + i * 8 + ty) * (ldw_) + _sc] : 0.f; } while (0)
__device__ __forceinline__ void transpose_all(const Params& P, char* smem) {
    constexpr int T_IN = (NINP / 64) * 32, T_O = 64 * 32, TOTAL = T_IN + T_O + 16 * 32;
    float* T = (float*)smem;
    const int tid = threadIdx.x, tx = tid & 63, ty = tid >> 6;
    int it = blockIdx.x;
    if (it >= TOTAL) return;
    const float* W; bf16_t* Wt; int ldw, n0, k0, mode;
    TILE_JOB(it, W, Wt, ldw, n0, k0, mode);
    float r[16];
    TILE_LOAD(W, ldw, n0, k0, mode);
    for (;;) {
#pragma unroll
        for (int i = 0; i < 16; ++i) T[(i * 8 + ty) * 65 + tx] = r[i];
        __syncthreads();
        bf16_t* cWt = Wt; const int cn0 = n0, ck0 = k0;
        const int nit = it + gridDim.x;
        const bool more = nit < TOTAL;
        if (more) { TILE_JOB(nit, W, Wt, ldw, n0, k0, mode); TILE_LOAD(W, ldw, n0, k0, mode); }
#pragma unroll
        for (int i = 0; i < 8; ++i) {
            const int n = i * 8 + ty, k = tx * 2;
            *(unsigned*)(cWt + (size_t)(cn0 + n) * D + ck0 + k) = pk_bf16(T[k * 65 + n], T[(k + 1) * 65 + n]);
        }
        __syncthreads();
        if (!more) break;
        it = nit;
    }
}
#undef TILE_JOB
#undef TILE_LOAD
__device__ __forceinline__ void rmsnorm_rows(const float* __restrict__ X, const float* __restrict__ gn, bf16_t* __restrict__ dst) {
    const int lane = threadIdx.x & 63, w = threadIdx.x >> 6;
    for (int row = blockIdx.x * NWV + w; row < S; row += gridDim.x * NWV) {
        const f32x4* xr = (const f32x4*)(X + (size_t)row * D) + lane;
        f32x4 v[16]; float ss = 0.f;
#pragma unroll
        for (int i = 0; i < 16; ++i) { v[i] = xr[i * 64]; ss += v[i][0] * v[i][0] + v[i][1] * v[i][1] + v[i][2] * v[i][2] + v[i][3] * v[i][3]; }
        ss = wave_sum(ss);
        const float r = rsqrtf(ss * (1.0f / 4096.0f) + 1e-6f);
        u32x2* dr = (u32x2*)(dst + (size_t)row * D) + lane;
#pragma unroll
        for (int i = 0; i < 16; ++i) {
            const f32x4 gg = ((const f32x4*)gn)[i * 64 + lane];
            u32x2 o; o.x = pk_bf16(v[i][0] * r * gg[0], v[i][1] * r * gg[1]); o.y = pk_bf16(v[i][2] * r * gg[2], v[i][3] * r * gg[3]);
            dr[i * 64] = o;
        }
    }
}

__device__ __forceinline__ void phase0(const Params& P, char* smem) {
    char* ws = P.ws;
    rmsnorm_rows(P.x, P.ln1, (bf16_t*)(ws + O_H));
    transpose_all(P, smem);
    bf16_t* K1 = (bf16_t*)(ws + O_K1); bf16_t* K2 = (bf16_t*)(ws + O_K2);
    for (int i = blockIdx.x * NT + threadIdx.x; i < 8 * 128 * 64; i += gridDim.x * NT) {
        const int hd = i >> 13, n = (i >> 6) & 127, d = i & 63;
        const int o = ((hd * 8 + (d >> 3)) * 128 + n) * 8 + (d & 7);
        K1[o] = f2bf(P.k1[i]); K2[o] = f2bf(P.k2[i]);
    }
}

namespace pg8 {
#define PG8_LAS __attribute__((address_space(3)))
typedef unsigned short bf16_t;
typedef short bf16x8 __attribute__((ext_vector_type(8)));
typedef float f32x4 __attribute__((ext_vector_type(4)));
typedef unsigned u32x4 __attribute__((ext_vector_type(4)));
constexpr int BM = 256, BK = 64, HALF = 128, HTB = HALF * BK * 2  , STAGE_BYTES = 8 * HTB, NXCD = 8, WGM = 8;

__host__ __device__ __forceinline__ int lds_byte(int r, int c) { const int st = (r >> 4) * 2 + (c >> 5), rr = r & 15, cc = c & 31, ob = rr * 64 + cc * 2; return st * 1024 + (ob ^ (((ob >> 9) & 1) << 5)); }
__host__ __device__ __forceinline__ void stage_rc(int b, int& R, int& C) { const int st = b / 1024, sb = b % 1024, swz = sb ^ (((sb >> 9) & 1) << 5); R = (st >> 1) * 16 + swz / 64; C = (st & 1) * 32 + (swz % 64) / 2; }
__host__ __device__ __forceinline__ int perm32(int rho) { const int n = rho >> 4, i = rho & 15; return 8 * (i >> 2) + 4 * n + (i & 3); }

struct Unit { int pm, pn; };
struct Gemm { const bf16_t* A; const bf16_t* Bt; int M, N, K; };

struct StaticOrder {
    int nM, nN, nwg, G, c;
    __host__ __device__ void init(int M, int N, int G_, int c_) { nM = M / BM; nN = N / BM; nwg = nM * nN; G = G_; c = c_; }
    __host__ __device__ bool next(int i, Unit& u) const {
        const long L = (long)i * G + c; if (L >= nwg) return false;
        int wgid = (int)L; { const int q = nwg / NXCD, r = nwg % NXCD, xcd = wgid % NXCD, off = wgid / NXCD; wgid = (xcd < r ? xcd * (q + 1) : r * (q + 1) + (xcd - r) * q) + off; }
        const int nig = WGM * nN, gid = wgid / nig, fm = gid * WGM, gsz = (nM - fm) < WGM ? (nM - fm) : WGM;
        u.pm = fm + ((wgid % nig) % gsz); u.pn = (wgid % nig) / gsz; return true;
    }
    __device__ __forceinline__ void a_ready(const Unit&) const {}
    __device__ __forceinline__ void done(const Unit&) const {}
};


__device__ __forceinline__ unsigned epk(float lo, float hi) { typedef float v2f __attribute__((ext_vector_type(2))); typedef __bf16 v2b __attribute__((ext_vector_type(2))); const v2f v = {lo, hi}; return __builtin_bit_cast(unsigned, __builtin_convertvector(v, v2b)); }
struct EpiInProj {
    static constexpr bool PERM = true, AFTER_DRAIN = false;
    bf16_t* proj; bf16_t* fvt; int ldp; int seq;
    __device__ __forceinline__ void operator()(const f32x4 (&acc)[2][2][4][2], const Unit& u, int wr, int wc, int fr, int fq) const {
        if (u.pn >= 16 && u.pn < 24) {
#pragma unroll
            for (int ai = 0; ai < 2; ++ai)
#pragma unroll
                for (int bj = 0; bj < 2; ++bj)
#pragma unroll
                    for (int m = 0; m < 4; ++m) {
                        const size_t r = (size_t)u.pm * BM + ai * HALF + wr * 64 + m * 16 + fr;
#pragma unroll
                        for (int n = 0; n < 2; ++n)
#pragma unroll
                            for (int j = 0; j < 4; ++j) {
                                const size_t d = (size_t)((u.pn - 16) * 2 + bj) * 128 + wc * 32 + fq * 8 + n * 4 + j;
                                fvt[d * seq + r] = (bf16_t)(epk(acc[ai][bj][m][n][j], 0.f) & 0xffffu);
                            }
                    }
        } else {
#pragma unroll
            for (int ai = 0; ai < 2; ++ai)
#pragma unroll
                for (int m = 0; m < 4; ++m) {
                    bf16_t* rowp = proj + ((size_t)u.pm * BM + ai * HALF + wr * 64 + m * 16 + fr) * ldp + u.pn * BM + wc * 32 + fq * 8;
#pragma unroll
                    for (int bj = 0; bj < 2; ++bj) {
                        u32x4 w;
                        w.x = epk(acc[ai][bj][m][0][0], acc[ai][bj][m][0][1]); w.y = epk(acc[ai][bj][m][0][2], acc[ai][bj][m][0][3]);
                        w.z = epk(acc[ai][bj][m][1][0], acc[ai][bj][m][1][1]); w.w = epk(acc[ai][bj][m][1][2], acc[ai][bj][m][1][3]);
                        *(u32x4*)(rowp + bj * HALF) = w;
                    }
                }
        }
    }
};
struct EpiResid {
    static constexpr bool PERM = true, AFTER_DRAIN = false;
    const float* x; float* out; int ld; const float* g2; bf16_t* a2; float* part;
    __device__ __forceinline__ void operator()(const f32x4 (&acc)[2][2][4][2], const Unit& u, int wr, int wc, int fr, int fq) const {
        f32x4 gv[2][2];
#pragma unroll
        for (int bj = 0; bj < 2; ++bj)
#pragma unroll
            for (int n = 0; n < 2; ++n) gv[bj][n] = *(const f32x4*)(g2 + u.pn * BM + wc * 32 + fq * 8 + bj * HALF + n * 4);
#pragma unroll
        for (int ai = 0; ai < 2; ++ai)
#pragma unroll
            for (int m = 0; m < 4; ++m) {
                const size_t row = (size_t)u.pm * BM + ai * HALF + wr * 64 + m * 16 + fr;
                const size_t o = row * ld + u.pn * BM + wc * 32 + fq * 8;
                float ss = 0.f;
#pragma unroll
                for (int bj = 0; bj < 2; ++bj) {
                    u32x4 w;
#pragma unroll
                    for (int n = 0; n < 2; ++n) {
                        const f32x4 v = *(const f32x4*)(x + o + bj * HALF + n * 4) + acc[ai][bj][m][n];
                        *(f32x4*)(out + o + bj * HALF + n * 4) = v;
                        ss += (v[0] * v[0] + v[1] * v[1]) + (v[2] * v[2] + v[3] * v[3]);
                        const f32x4 gq = v * gv[bj][n];
                        w[2 * n] = epk(gq[0], gq[1]); w[2 * n + 1] = epk(gq[2], gq[3]);
                    }
                    *(u32x4*)(a2 + o + bj * HALF) = w;
                }
                ss += __shfl_xor(ss, 16); ss += __shfl_xor(ss, 32);
                if (fq == 0) part[row * 64 + u.pn * 4 + wc] = ss;
            }
    }
};
struct EpiStoreBf16 {
    static constexpr bool PERM = true, AFTER_DRAIN = false;
    bf16_t* O; int ld;
    __device__ __forceinline__ void operator()(const f32x4 (&acc)[2][2][4][2], const Unit& u, int wr, int wc, int fr, int fq) const {
#pragma unroll
        for (int ai = 0; ai < 2; ++ai)
#pragma unroll
            for (int m = 0; m < 4; ++m) {
                bf16_t* rowp = O + ((size_t)u.pm * BM + ai * HALF + wr * 64 + m * 16 + fr) * ld + u.pn * BM + wc * 32 + fq * 8;
#pragma unroll
                for (int bj = 0; bj < 2; ++bj) {
                    u32x4 w;
                    w.x = epk(acc[ai][bj][m][0][0], acc[ai][bj][m][0][1]); w.y = epk(acc[ai][bj][m][0][2], acc[ai][bj][m][0][3]);
                    w.z = epk(acc[ai][bj][m][1][0], acc[ai][bj][m][1][1]); w.w = epk(acc[ai][bj][m][1][2], acc[ai][bj][m][1][3]);
                    *(u32x4*)(rowp + bj * HALF) = w;
                }
            }
    }
};

template <class Epi, class Sched, bool ALIGN_EPI = false, bool SP2 = false>
__device__ __forceinline__ void gemm_phase(PG8_LAS unsigned char* lds, const Gemm g, const Sched& S, const Epi& E) {
    const int tid = threadIdx.x, wid = __builtin_amdgcn_readfirstlane(tid >> 6), lane = tid & 63, wr = wid >> 2, wc = wid & 3, fr = lane & 15, fq = lane >> 4;
    const int K = g.K, nt = K / BK;
    unsigned voffA[2], voffB[2];
#pragma unroll
    for (int i = 0; i < 2; ++i) { int R, C; stage_rc(tid * 16 + i * 8192, R, C); const int Rb = Epi::PERM ? ((R & ~31) + perm32(R & 31)) : R;
        voffA[i] = (unsigned)(R * K + C) * 2u; voffB[i] = (unsigned)(Rb * K + C) * 2u; }
    const size_t kstep = (size_t)(BK * 2);
    const size_t hstep = (size_t)HALF * K * 2;
    const size_t tstep = 2 * hstep;
    const unsigned ldsw = (unsigned)wid * 1024u;
    const int aoff = lds_byte(wr * 64 + fr, fq * 8), boff = lds_byte(wc * 32 + fr, fq * 8);
#define PG8_SA(b, h) (((b) * 2 + (h)) * HTB)
#define PG8_SB(b, h) ((4 + (b) * 2 + (h)) * HTB)
#define PG8_STAGE(bufoff, gbase, voff) do { _Pragma("unroll") for (int _i = 0; _i < 2; ++_i) \
        __builtin_amdgcn_global_load_lds((const unsigned*)((const char*)(gbase) + (voff)[_i]), (PG8_LAS unsigned*)(lds + (bufoff) + ldsw + _i * 8192), 16, 0, 0); } while (0)
#define PG8_LDA(dst, b, h) do { _Pragma("unroll") for (int m = 0; m < 4; ++m) _Pragma("unroll") for (int k = 0; k < 2; ++k) dst[m][k] = *(const PG8_LAS bf16x8*)(lds + PG8_SA(b, h) + aoff + m * 2048 + k * 1024); } while (0)
#define PG8_LDB(dst, b, h) do { _Pragma("unroll") for (int n = 0; n < 2; ++n) _Pragma("unroll") for (int k = 0; k < 2; ++k) dst[n][k] = *(const PG8_LAS bf16x8*)(lds + PG8_SB(b, h) + boff + n * 2048 + k * 1024); } while (0)
#define PG8_MMA(ai, bj, At, Bt) do { __builtin_amdgcn_s_setprio(1); _Pragma("unroll") for (int m = 0; m < 4; ++m) _Pragma("unroll") for (int n = 0; n < 2; ++n) _Pragma("unroll") for (int k = 0; k < 2; ++k) \
        acc[ai][bj][m][n] = __builtin_amdgcn_mfma_f32_16x16x32_bf16(Bt[n][k], At[m][k], acc[ai][bj][m][n], 0, 0, 0); __builtin_amdgcn_s_setprio(0); } while (0)
#define PG8_WAIT_V(n) asm volatile("s_waitcnt vmcnt(" #n ")" ::: "memory")
#define PG8_WAIT_L(n) asm volatile("s_waitcnt lgkmcnt(" #n ")" ::: "memory")
#define PG8_BAR __builtin_amdgcn_s_barrier()
#define PG8_SCHED __builtin_amdgcn_sched_barrier(0)
    Unit cur, nxt; int ui = 0;
    if (!S.next(0, cur)) return;
    f32x4 acc[2][2][4][2];
#pragma unroll
    for (int a = 0; a < 2; ++a)
#pragma unroll
        for (int b = 0; b < 2; ++b)
#pragma unroll
            for (int m = 0; m < 4; ++m)
#pragma unroll
                for (int n = 0; n < 2; ++n) acc[a][b][m][n] = (f32x4){0.f, 0.f, 0.f, 0.f};
    bf16x8 At[4][2], B0[2][2], B1[2][2];
    const char* cA = (const char*)g.A + (size_t)cur.pm * tstep; const char* cB = (const char*)g.Bt + (size_t)cur.pn * tstep;
    S.a_ready(cur);
    if constexpr (SP2) {
        PG8_STAGE(PG8_SB(0, 0), cB, voffB); PG8_STAGE(PG8_SB(0, 1), cB + hstep, voffB); PG8_STAGE(PG8_SA(0, 0), cA, voffA); PG8_STAGE(PG8_SA(0, 1), cA + hstep, voffA);
        if (wr == 1) PG8_BAR;
        PG8_WAIT_V(2); PG8_BAR;
        PG8_STAGE(PG8_SB(1, 0), cB + kstep, voffB); PG8_STAGE(PG8_SA(1, 0), cA + kstep, voffA); PG8_STAGE(PG8_SB(1, 1), cB + hstep + kstep, voffB);
        PG8_WAIT_V(6); PG8_BAR;
    } else {
        PG8_STAGE(PG8_SB(0, 0), cB, voffB); PG8_STAGE(PG8_SA(0, 0), cA, voffA); PG8_STAGE(PG8_SB(0, 1), cB + hstep, voffB); PG8_STAGE(PG8_SA(0, 1), cA + hstep, voffA);
        if (wr == 1) PG8_BAR;
        PG8_WAIT_V(4); PG8_BAR;
        PG8_STAGE(PG8_SB(1, 0), cB + kstep, voffB); PG8_STAGE(PG8_SA(1, 0), cA + kstep, voffA); PG8_STAGE(PG8_SB(1, 1), cB + hstep + kstep, voffB);
        PG8_WAIT_V(6); PG8_BAR;
    }
    for (;;) {
        const bool has_next = S.next(ui + 1, nxt);
        const char* nA = has_next ? (const char*)g.A + (size_t)nxt.pm * tstep : cA; const char* nB = has_next ? (const char*)g.Bt + (size_t)nxt.pn * tstep : cB;
        for (int t = 0; t < nt; t += 2) {
            const bool last = (t == nt - 2);
            const char* a1 = cA + (size_t)(t + 1) * kstep;
            const char* a2 = last ? nA : cA + (size_t)(t + 2) * kstep; const char* b2 = last ? nB : cB + (size_t)(t + 2) * kstep;
            const char* a3 = a2 + kstep; const char* b3 = b2 + kstep;
            if (last && has_next) S.a_ready(nxt);
            if constexpr (SP2) {
            PG8_LDB(B0, 0, 0); PG8_LDB(B1, 0, 1); PG8_SCHED; PG8_LDA(At, 0, 0); PG8_STAGE(PG8_SA(1, 1), a1 + hstep, voffA);
            PG8_WAIT_V(8); PG8_WAIT_L(0); PG8_BAR; PG8_MMA(0, 0, At, B0); PG8_MMA(0, 1, At, B1); PG8_BAR; PG8_SCHED;
            PG8_LDA(At, 0, 1); PG8_STAGE(PG8_SB(0, 0), b2, voffB); PG8_STAGE(PG8_SB(0, 1), b2 + hstep, voffB); PG8_STAGE(PG8_SA(0, 0), a2, voffA);
            PG8_WAIT_V(8); PG8_WAIT_L(0); PG8_BAR; PG8_MMA(1, 0, At, B0); PG8_MMA(1, 1, At, B1); PG8_BAR; PG8_SCHED;
            PG8_LDB(B0, 1, 0); PG8_LDB(B1, 1, 1); PG8_SCHED; PG8_LDA(At, 1, 0); PG8_STAGE(PG8_SA(0, 1), a2 + hstep, voffA);
            PG8_WAIT_V(8); PG8_WAIT_L(0); PG8_BAR; PG8_MMA(0, 0, At, B0); PG8_MMA(0, 1, At, B1); PG8_BAR; PG8_SCHED;
            PG8_LDA(At, 1, 1); PG8_STAGE(PG8_SB(1, 0), b3, voffB); PG8_STAGE(PG8_SB(1, 1), b3 + hstep, voffB); PG8_STAGE(PG8_SA(1, 0), a3, voffA);
            PG8_WAIT_V(8); PG8_WAIT_L(0); PG8_BAR; PG8_MMA(1, 0, At, B0); PG8_MMA(1, 1, At, B1); PG8_BAR; PG8_SCHED;
            } else {
            PG8_LDB(B0, 0, 0); PG8_SCHED; PG8_LDA(At, 0, 0); PG8_STAGE(PG8_SA(1, 1), a1 + hstep, voffA);
            PG8_WAIT_L(8); PG8_BAR; PG8_WAIT_L(0); PG8_MMA(0, 0, At, B0); PG8_BAR; PG8_SCHED;
            PG8_LDB(B1, 0, 1); PG8_STAGE(PG8_SB(0, 0), b2, voffB);
            PG8_BAR; PG8_WAIT_L(0); PG8_MMA(0, 1, At, B1); PG8_BAR;
            PG8_LDA(At, 0, 1); PG8_STAGE(PG8_SA(0, 0), a2, voffA);
            PG8_BAR; PG8_WAIT_L(0); PG8_MMA(1, 0, At, B0); PG8_BAR; PG8_SCHED;
            PG8_STAGE(PG8_SB(0, 1), b2 + hstep, voffB);
            PG8_WAIT_V(6); PG8_BAR; PG8_MMA(1, 1, At, B1); PG8_BAR;
            PG8_LDB(B0, 1, 0); PG8_SCHED; PG8_LDA(At, 1, 0); PG8_STAGE(PG8_SA(0, 1), a2 + hstep, voffA);
            PG8_WAIT_L(8); PG8_BAR; PG8_WAIT_L(0); PG8_MMA(0, 0, At, B0); PG8_BAR; PG8_SCHED;
            PG8_LDB(B1, 1, 1); PG8_STAGE(PG8_SB(1, 0), b3, voffB);
            PG8_BAR; PG8_WAIT_L(0); PG8_MMA(0, 1, At, B1); PG8_BAR;
            PG8_LDA(At, 1, 1); PG8_STAGE(PG8_SA(1, 0), a3, voffA);
            PG8_BAR; PG8_WAIT_L(0); PG8_MMA(1, 0, At, B0); PG8_BAR; PG8_SCHED;
            PG8_STAGE(PG8_SB(1, 1), b3 + hstep, voffB);
            PG8_WAIT_V(6); PG8_BAR; PG8_MMA(1, 1, At, B1); PG8_BAR;
            }
        }
        if constexpr (ALIGN_EPI) { if (wr == 0) PG8_BAR; }
        if constexpr (!Epi::AFTER_DRAIN) { E(acc, cur, wr, wc, fr, fq); S.done(cur); }
        if (!has_next) break;
#pragma unroll
        for (int a = 0; a < 2; ++a)
#pragma unroll
            for (int b = 0; b < 2; ++b)
#pragma unroll
                for (int m = 0; m < 4; ++m)
#pragma unroll
                    for (int n = 0; n < 2; ++n) acc[a][b][m][n] = (f32x4){0.f, 0.f, 0.f, 0.f};
        cur = nxt; cA = nA; cB = nB; ++ui;
        if constexpr (ALIGN_EPI) { if (wr == 1) PG8_BAR; }
    }
    PG8_WAIT_V(0);
    if constexpr (!ALIGN_EPI) { if (wr == 0) PG8_BAR; }
    PG8_BAR;
    if constexpr (Epi::AFTER_DRAIN) { E.fused(acc, cur, wr, wc, fr, fq, lds, wid, lane); S.done(cur); }
#undef PG8_SA
#undef PG8_SB
#undef PG8_STAGE
#undef PG8_LDA
#undef PG8_LDB
#undef PG8_MMA
#undef PG8_WAIT_V
#undef PG8_WAIT_L
#undef PG8_BAR
#undef PG8_SCHED
}
}

constexpr int NCHUNK = 1024, NSPARE = 8;
__device__ __forceinline__ void convert_chunk(const Params& P, int c) {
    const bool isv = c >= 512; const int lc = c & 511;
    const float* src = (isv ? P.v : P.u);
    unsigned* dst = (unsigned*)(P.ws + (isv ? O_VB : O_UB));
    const float sc = isv ? V_SCALE : U_SCALE;
#pragma unroll 2
    for (int it = 0; it < 8; ++it) {
        const int gi = lc * 4096 + it * NT + threadIdx.x;
        const int row = gi >> 7, gr = gi & 127, l = gr >> 1;
        const f32x4* sp = (const f32x4*)(src + (size_t)row * 4096 + (gr & 1) * 2048 + 4 * l);
        v16f_t a, b;
#pragma unroll
        for (int q = 0; q < 8; ++q) {
            const f32x4 x = sp[q * 64] * sc;
            a[2 * q] = x[0]; b[2 * q] = x[1]; a[2 * q + 1] = x[2]; b[2 * q + 1] = x[3];
        }
        const v6u_t p = __builtin_amdgcn_cvt_scalef32_2xpk16_fp6_f32(a, b, 1.0f);
        unsigned* rowp = dst + (size_t)row * 768;
        if ((gr & 1) == 0) {
            *(u32x4*)(rowp + 4 * l) = (u32x4){p[0], p[1], p[2], p[3]};
            *(u32x2*)(rowp + 256 + 4 * l) = (u32x2){p[4], p[5]};
        } else {
            *(u32x2*)(rowp + 256 + 4 * l + 2) = (u32x2){p[0], p[1]};
            *(u32x4*)(rowp + 512 + 4 * l) = (u32x4){p[2], p[3], p[4], p[5]};
        }
    }
}
__device__ __forceinline__ void convert_loop(const Params& P, char* smem, const bool stop_when_gemm_done) {
    unsigned* ctr = (unsigned*)(P.ws + O_CTR);
    int* slot = (int*)(smem + 131072);
    for (;;) {
        __syncthreads();
        if (threadIdx.x == 0) {
            int c = NCHUNK;
            if (!(stop_when_gemm_done && __hip_atomic_load(ctr + 57, __ATOMIC_RELAXED, __HIP_MEMORY_SCOPE_AGENT) != 0u)) c = (int)atomicAdd(ctr + 56, 1u);
            *slot = c;
        }
        __syncthreads();
        const int c = *slot;
        if (c >= NCHUNK) break;
        convert_chunk(P, c);
    }
}

template <int MODE>
__device__ __forceinline__ void gemm_phase(const Params& P, char* smem) {
    char* ws = P.ws;
    PG8_LAS unsigned char* lds = (PG8_LAS unsigned char*)smem;
    pg8::StaticOrder so;
    if (MODE == 0) {
        const int Gg = (int)gridDim.x - NSPARE;
        if ((int)blockIdx.x >= Gg) { convert_loop(P, smem, true); return; }
        pg8::Gemm g{(const bf16_t*)(ws + O_H), (const bf16_t*)(ws + O_WTIN), S, NINP, D}; so.init(S, NINP, Gg, blockIdx.x);
        pg8::EpiInProj E{(bf16_t*)(ws + O_PROJ), (bf16_t*)(ws + O_FVT), NINP, S};
        pg8::gemm_phase<pg8::EpiInProj, pg8::StaticOrder, true, true>(lds, g, so, E);
        if (threadIdx.x == 0) __hip_atomic_store((unsigned*)(ws + O_CTR) + 57, 1u, __ATOMIC_RELAXED, __HIP_MEMORY_SCOPE_AGENT);
    } else if (MODE == 1) {
        pg8::Gemm g{(const bf16_t*)(ws + O_MIX), (const bf16_t*)(ws + O_WTO), S, D, D}; so.init(S, D, gridDim.x, blockIdx.x);
        pg8::EpiResid E{P.x, P.out, D, P.ln2, (bf16_t*)(ws + O_H2), (float*)(ws + O_PART)};
        pg8::gemm_phase<pg8::EpiResid, pg8::StaticOrder, true, true>(lds, g, so, E);
    } else {
        pg8::Gemm g{(const bf16_t*)(ws + O_H2), (const bf16_t*)(ws + O_WTQ), S, 1024, D}; so.init(S, 1024, gridDim.x, blockIdx.x);
        pg8::EpiStoreBf16 E{(bf16_t*)(ws + O_QP), 1024};
        pg8::gemm_phase<pg8::EpiStoreBf16, pg8::StaticOrder, false, true>(lds, g, so, E);
        convert_loop(P, smem, false);
    }
}

__device__ __forceinline__ float row16_sum(float v) {
#define ROR_(x, n) __builtin_bit_cast(float, __builtin_amdgcn_update_dpp(0, __builtin_bit_cast(int, x), 0x120 + (n), 0xf, 0xf, true))
    v += ROR_(v, 8); v += ROR_(v, 4); v += ROR_(v, 2); v += ROR_(v, 1);
    return v;
}
__device__ __forceinline__ void post_phase(const Params& P) {
    char* ws = P.ws;
    const bf16_t* PROJ = (const bf16_t*)(ws + O_PROJ);
    const int lane = threadIdx.x & 63, w = threadIdx.x >> 6, li = lane & 15, gq = lane >> 4;
    const int nw = gridDim.x * NWV;
    constexpr int NPT = 59;
    float inv128v[8], inv64v[8];
#pragma unroll
    for (int e = 0; e < 8; ++e) {
        inv128v[e] = exp2f(-(float)((li & 7) * 8 + e) * (2.0f / 128.0f) * 13.287712379549449f);
        inv64v[e] = exp2f(-(float)((li & 3) * 8 + e) * (2.0f / 64.0f) * 13.287712379549449f);
    }
    for (int base = (blockIdx.x * NWV + w) * 4; base < NPT * S; base += nw * 4) {
        const int unit = base + gq;
        const int k = unit >> 13, row = unit & (S - 1);
        const int tn = k < 32 ? k : k + 16;
        const u32x4 rawv = *(const u32x4*)(PROJ + (size_t)row * NINP + tn * 128 + li * 8);
        float v[8];
#pragma unroll
        for (int q = 0; q < 4; ++q) { v[2 * q] = bf_lo(rawv[q]); v[2 * q + 1] = bf_hi(rawv[q]); }
        if (tn <= 64) {
            const float* gp = (tn < 16 ? P.fqg : tn < 32 ? P.fkg : tn < 64 ? P.dqg : P.dkg) + li * 8;
            const f32x4 ga = *(const f32x4*)gp, gb = *(const f32x4*)(gp + 4);
            float ss = 0.f;
#pragma unroll
            for (int e = 0; e < 8; ++e) ss += v[e] * v[e];
            ss = row16_sum(ss);
            const float r = rsqrtf(ss * (1.0f / 128.0f) + 1e-6f);
            float a[8];
#pragma unroll
            for (int e = 0; e < 8; ++e) a[e] = v[e] * r * (e < 4 ? ga[e] : gb[e - 4]);
            if (tn >= 48) {
                const float posf = (float)P.pos[row];
#pragma unroll
                for (int e = 0; e < 8; ++e) {
                    const float pr = ROR_(a[e], 8);
                    float sn, cs; sincos_f(posf * inv128v[e], sn, cs);
                    a[e] = li < 8 ? a[e] * cs - pr * sn : a[e] * cs + pr * sn;
                }
            }
            const float osc = (tn < 16 || (tn >= 48 && tn < 64)) ? QSCALE : 1.f;
            bf16_t* dst;
            if (tn < 16) dst = (bf16_t*)(ws + O_FQ) + ((size_t)tn * S + row) * 128;
            else if (tn < 32) dst = (bf16_t*)(ws + O_FK) + ((size_t)(tn - 16) * S + row) * 128;
            else if (tn < 64) dst = (bf16_t*)(ws + O_DQ) + ((size_t)row * 16 + (tn - 48)) * 128;
            else dst = (bf16_t*)(ws + O_DK) + (size_t)row * 128;
            u32x4 o;
#pragma unroll
            for (int q = 0; q < 4; ++q) o[q] = pk_bf16(a[2 * q] * osc, a[2 * q + 1] * osc);
            *(u32x4*)(dst + li * 8) = o;
        } else if (tn == 65) {
            *(u32x4*)((bf16_t*)(ws + O_DV) + (size_t)row * 128 + li * 8) = rawv;
        } else {
            const bool misc = tn == 74;
            if (!misc || li < 8) {
                const float posf = (float)P.pos[row];
                float a[8];
#pragma unroll
                for (int e = 0; e < 8; ++e) {
                    const float pr = __shfl_xor(v[e], 4);
                    float sn, cs; sincos_f(posf * inv64v[e], sn, cs);
                    a[e] = (li & 4) == 0 ? v[e] * cs - pr * sn : v[e] * cs + pr * sn;
                }
                u32x4 o;
#pragma unroll
                for (int q = 0; q < 4; ++q) o[q] = pk_bf16(a[2 * q], a[2 * q + 1]);
                bf16_t* dst = misc ? (bf16_t*)(ws + O_IK) + (size_t)row * 64 + li * 8
                                   : (bf16_t*)(ws + O_IQ) + ((size_t)row * 16 + (tn - 66) * 2 + (li >> 3)) * 64 + (li & 7) * 8;
                *(u32x4*)dst = o;
            } else if (li < 10) {
#pragma unroll
                for (int e = 0; e < 8; ++e) {
                    const int hh = (li - 8) * 8 + e;
                    const float z = v[e] + P.fb[hh];
                    ((float*)(ws + O_LOGF))[(size_t)hh * S + row] = fminf(z, 0.f) - log1pf(expf(-fabsf(z)));
                }
            } else if (li < 12) {
                float* dst = (float*)(ws + O_IW) + (size_t)row * 16 + (li - 10) * 8;
                *(f32x4*)dst = (f32x4){v[0], v[1], v[2], v[3]} * 0.03125f;
                *(f32x4*)(dst + 4) = (f32x4){v[4], v[5], v[6], v[7]} * 0.03125f;
            }
        }
    }
#undef ROR_
}

__device__ __forceinline__ void phase2(const Params& P, char* smem) {
    char* ws = P.ws;
    const int tid = threadIdx.x, lane = tid & 63, w = tid >> 6, lm = lane & 15, g = lane >> 4;
    for (int h = blockIdx.x; h < 16; h += gridDim.x) {
        const float* lf = (const float*)(ws + O_LOGF) + (size_t)h * S + tid * 16;
        float* cu = (float*)(ws + O_CUM) + (size_t)h * S + tid * 16;
        double* part = (double*)smem;
        f32x4 v[4]; double s = 0.0;
#pragma unroll
        for (int i = 0; i < 4; ++i) { v[i] = *(const f32x4*)(lf + i * 4); s += (double)v[i][0] + (double)v[i][1] + (double)v[i][2] + (double)v[i][3]; }
        double inc = s;
#pragma unroll
        for (int o = 1; o < 64; o <<= 1) { const double up = __shfl_up(inc, o); if (lane >= o) inc += up; }
        __syncthreads();
        if (lane == 63) part[w] = inc;
        __syncthreads();
        double run = inc - s;
        for (int i = 0; i < w; ++i) run += part[i];
#pragma unroll
        for (int i = 0; i < 4; ++i) {
            f32x4 o;
#pragma unroll
            for (int r = 0; r < 4; ++r) { run += (double)v[i][r]; o[r] = (float)(run * 1.4426950408889634); }
            *(f32x4*)(cu + i * 4) = o;
        }
        __syncthreads();
    }
    const bf16_t* IQ = (const bf16_t*)(ws + O_IQ); const bf16_t* IK = (const bf16_t*)(ws + O_IK); const float* IW = (const float*)(ws + O_IW);
    float* SC = (float*)(ws + O_SC);
    for (int it = blockIdx.x; it < 2080; it += gridDim.x) {
        int qb = (int)((sqrtf(8.f * (float)it + 1.f) - 1.f) * 0.5f);
        while (qb * (qb + 1) / 2 > it) --qb;
        while ((qb + 1) * (qb + 2) / 2 <= it) ++qb;
        const int kc = it - qb * (qb + 1) / 2;
        const int q0 = qb * 128 + w * 16, k0 = kc * 128;
        if (k0 > q0 + 15) continue;
        bf16x8 af[8][2];
#pragma unroll
        for (int st = 0; st < 8; ++st)
#pragma unroll
            for (int ks = 0; ks < 2; ++ks) af[st][ks] = *(const bf16x8*)(IK + (size_t)(k0 + st * 16 + lm) * 64 + ks * 32 + g * 8);
        f32x4 sc[8];
#pragma unroll
        for (int st = 0; st < 8; ++st) sc[st] = (f32x4){0.f, 0.f, 0.f, 0.f};
        const bf16_t* qp = IQ + (size_t)(q0 + lm) * 16 * 64 + g * 8;
        const float* wp = IW + (size_t)(q0 + lm) * 16;
        bf16x8 b0 = *(const bf16x8*)qp, b1 = *(const bf16x8*)(qp + 32);
        float wh = wp[0];
#pragma unroll 1
        for (int h = 0; h < 16; ++h) {
            const int hn = h < 15 ? h + 1 : 15;
            const bf16x8 nb0 = *(const bf16x8*)(qp + hn * 64), nb1 = *(const bf16x8*)(qp + hn * 64 + 32);
            const float nwh = wp[hn];
#pragma unroll
            for (int st = 0; st < 8; ++st) {
                f32x4 c = (f32x4){0.f, 0.f, 0.f, 0.f};
                c = mfma(af[st][0], b0, c); c = mfma(af[st][1], b1, c);
#pragma unroll
                for (int r4 = 0; r4 < 4; ++r4) sc[st][r4] += wh * fmaxf(c[r4], 0.f);
            }
            b0 = nb0; b1 = nb1; wh = nwh;
        }
#pragma unroll
        for (int st = 0; st < 8; ++st) {
            typedef _Float16 h4_t __attribute__((ext_vector_type(4)));
            *(h4_t*)((_Float16*)SC + (size_t)(q0 + lm) * S + k0 + st * 16 + g * 4) = __builtin_convertvector(sc[st], h4_t);
        }
    }
}

__device__ __forceinline__ void fox_item(const Params& P, int h, int qt, char* smem) {
    char* ws = P.ws;
    bf16_t* Ks = (bf16_t*)smem;
    bf16_t* Vs = (bf16_t*)(smem + 17408);
    float* Cs = (float*)(smem + 35840);
    const int tid = threadIdx.x, lane = tid & 63, w = tid >> 6, lm = lane & 15, g = lane >> 4;
    const int q0 = qt * 256, qw0 = q0 + w * 32;
    const bf16_t* FQh = (const bf16_t*)(ws + O_FQ) + (size_t)h * S * 128;
    const bf16_t* FKh = (const bf16_t*)(ws + O_FK) + (size_t)h * S * 128;
    const bf16_t* FVh = (const bf16_t*)(ws + O_FVT) + (size_t)h * 128 * S;
    const float* cumh = (const float*)(ws + O_CUM) + (size_t)h * S;
    bf16x8 qf[2][4]; float ct[2];
#pragma unroll
    for (int nt = 0; nt < 2; ++nt) {
        const int qrow = qw0 + nt * 16 + lm;
#pragma unroll
        for (int ks = 0; ks < 4; ++ks) qf[nt][ks] = *(const bf16x8*)(FQh + (size_t)qrow * 128 + ks * 32 + g * 8);
        ct[nt] = cumh[qrow];
    }
    f32x4 o[2][8];
#pragma unroll
    for (int nt = 0; nt < 2; ++nt)
#pragma unroll
        for (int dt = 0; dt < 8; ++dt) o[nt][dt] = (f32x4){0.f, 0.f, 0.f, 0.f};
    float lrun[2] = {0.f, 0.f};
    const int nkt = qt * 4 + 4;
    int kt0 = 0; float lbound = 0.f;
    {
        float mq = fmaxf(fabsf(P.fqg[lane]), fabsf(P.fqg[lane + 64])), mk = fmaxf(fabsf(P.fkg[lane]), fabsf(P.fkg[lane + 64]));
#pragma unroll
        for (int o2 = 32; o2; o2 >>= 1) { mq = fmaxf(mq, __shfl_xor(mq, o2)); mk = fmaxf(mk, __shfl_xor(mk, o2)); }
        lbound = 128.0f * QSCALE * mq * mk * 1.01f;
        const float thr = cumh[q0] + 2.0f * lbound + 40.0f;
        int lo = 0, hi = qt * 4;
        while (lo < hi) { const int mid = (lo + hi) >> 1; if (cumh[mid * 64 + 63] <= thr) hi = mid; else lo = mid + 1; }
        kt0 = lo;
    }
    u32x4 rk[2], rv[2]; float rc = 0.f;
    const int krow_s = tid >> 4, kcc_s = tid & 15, vrow_s = tid >> 3, vcc_s = tid & 7;
#pragma unroll
    for (int i = 0; i < 2; ++i) {
        rk[i] = *(const u32x4*)(FKh + (size_t)(kt0 * 64 + krow_s + i * 32) * 128 + kcc_s * 8);
        rv[i] = *(const u32x4*)(FVh + (size_t)(vrow_s + i * 64) * S + kt0 * 64 + vcc_s * 8);
    }
    if (tid < 64) rc = cumh[kt0 * 64 + tid];
    for (int kt = kt0; kt < nkt; ++kt) {
        __syncthreads();
#pragma unroll
        for (int i = 0; i < 2; ++i) {
            *(u32x4*)(Ks + (krow_s + i * 32) * 136 + kcc_s * 8) = rk[i];
            *(u32x4*)(Vs + (vrow_s + i * 64) * 72 + vcc_s * 8) = rv[i];
        }
        if (tid < 64) Cs[tid] = rc;
        __syncthreads();
        if (kt + 1 < nkt) {
            const int kb1 = (kt + 1) * 64;
#pragma unroll
            for (int i = 0; i < 2; ++i) {
                rk[i] = *(const u32x4*)(FKh + (size_t)(kb1 + krow_s + i * 32) * 128 + kcc_s * 8);
                rv[i] = *(const u32x4*)(FVh + (size_t)(vrow_s + i * 64) * S + kb1 + vcc_s * 8);
            }
            if (tid < 64) rc = cumh[kb1 + tid];
        }
        const int kb = kt * 64;
        if (kb <= qw0 + 31) {
            const bool diag = kb + 63 > qw0;
#pragma unroll 1
            for (int p = 0; p < 2; ++p) {
                f32x4 sa[2][2];
#pragma unroll
                for (int ab = 0; ab < 2; ++ab) {
                    const int krow = 32 * p + (lm >> 2) * 8 + ab * 4 + (lm & 3);
                    f32x4 c0 = (f32x4){0.f, 0.f, 0.f, 0.f}, c1 = c0;
#pragma unroll
                    for (int ks = 0; ks < 4; ++ks) {
                        const bf16x8 a = *(const bf16x8*)(Ks + krow * 136 + ks * 32 + g * 8);
                        c0 = mfma(a, qf[0][ks], c0); c1 = mfma(a, qf[1][ks], c1);
                    }
                    sa[ab][0] = c0; sa[ab][1] = c1;
                    asm volatile("" ::: "memory");
                }
                const f32x4 cs0 = *(const f32x4*)(Cs + 32 * p + g * 8), cs1 = *(const f32x4*)(Cs + 32 * p + g * 8 + 4);
                bf16x8 pf[2];
#pragma unroll
                for (int nt = 0; nt < 2; ++nt) {
                    const int qabs = qw0 + nt * 16 + lm;
                    const float ctm = ct[nt] - lbound;
                    float ls = 0.f;
#pragma unroll
                    for (int ab = 0; ab < 2; ++ab)
#pragma unroll
                        for (int r = 0; r < 4; ++r) {
                            float v = sa[ab][nt][r] + (ctm - (ab ? cs1[r] : cs0[r]));
                            if (diag && (kb + 32 * p + g * 8 + ab * 4 + r > qabs)) v = NEG_INF;
                            const float pv = __builtin_amdgcn_exp2f(v); sa[ab][nt][r] = pv; ls += pv;
                        }
                    lrun[nt] += ls;
                    u32x4 t4;
                    t4.x = pk_bf16(sa[0][nt][0], sa[0][nt][1]); t4.y = pk_bf16(sa[0][nt][2], sa[0][nt][3]);
                    t4.z = pk_bf16(sa[1][nt][0], sa[1][nt][1]); t4.w = pk_bf16(sa[1][nt][2], sa[1][nt][3]);
                    pf[nt] = __builtin_bit_cast(bf16x8, t4);
                }
#pragma unroll
                for (int dt = 0; dt < 8; ++dt) {
                    const bf16x8 a = *(const bf16x8*)(Vs + (dt * 16 + lm) * 72 + 32 * p + g * 8);
                    o[0][dt] = mfma(a, pf[0], o[0][dt]); o[1][dt] = mfma(a, pf[1], o[1][dt]);
                    if ((dt & 1) == 1) asm volatile("" ::: "memory");
                }
            }
        }
    }
    bf16_t* MIX = (bf16_t*)(ws + O_MIX);
#pragma unroll
    for (int nt = 0; nt < 2; ++nt) {
        float l = lrun[nt]; l += __shfl_xor(l, 16); l += __shfl_xor(l, 32);
        const float inv = 1.0f / l;
        const int qrow = qw0 + nt * 16 + lm;
#pragma unroll
        for (int dt = 0; dt < 8; ++dt) {
            u32x2 t2; t2.x = pk_bf16(o[nt][dt][0] * inv, o[nt][dt][1] * inv); t2.y = pk_bf16(o[nt][dt][2] * inv, o[nt][dt][3] * inv);
            *(u32x2*)(MIX + (size_t)qrow * D + h * 128 + dt * 16 + g * 4) = t2;
        }
    }
}

__device__ __forceinline__ int dpp_row_scan(int x) {
    x += __builtin_amdgcn_update_dpp(0, x, 0x111, 0xf, 0xf, true);
    x += __builtin_amdgcn_update_dpp(0, x, 0x112, 0xf, 0xf, true);
    x += __builtin_amdgcn_update_dpp(0, x, 0x114, 0xf, 0xf, true);
    x += __builtin_amdgcn_update_dpp(0, x, 0x118, 0xf, 0xf, true);
    return x;
}
__device__ __forceinline__ int wave_sum_i32(int x) {
    x = dpp_row_scan(x);
    return (__builtin_amdgcn_readlane(x, 15) + __builtin_amdgcn_readlane(x, 31)) + (__builtin_amdgcn_readlane(x, 47) + __builtin_amdgcn_readlane(x, 63));
}
__device__ __forceinline__ int wave_excl_scan_i32(int x, int& tot, const int lane) {
    const int sc = dpp_row_scan(x);
    const int t0 = __builtin_amdgcn_readlane(sc, 15), t1 = __builtin_amdgcn_readlane(sc, 31), t2 = __builtin_amdgcn_readlane(sc, 47), t3 = __builtin_amdgcn_readlane(sc, 63);
    tot = (t0 + t1) + (t2 + t3);
    return sc - x + (lane >= 16 ? t0 : 0) + (lane >= 32 ? t1 : 0) + (lane >= 48 ? t2 : 0);
}
template <int NJ>
__device__ __forceinline__ void wave_thresh256(const unsigned (&key)[NJ][4], const int jmax, unsigned& tg) {
    unsigned prefix = 0u;
    for (int bit = 31; bit >= 0; --bit) {
        const unsigned cand = prefix | (1u << bit);
        int lc = 0;
#pragma unroll
        for (int j = 0; j < NJ; ++j)
            if (j < jmax) {
#pragma unroll
                for (int c = 0; c < 4; ++c) lc += (key[j][c] >= cand) ? 1 : 0;
            }
        const int tot = wave_sum_i32(lc);
        if (tot >= 256) { prefix = cand; if (tot == 256) { prefix = cand - 1u; break; } }
    }
    tg = prefix;
}
__device__ __forceinline__ int wave_count_ge16(const unsigned (&key)[16][4], const int jmax, const unsigned cand) {
    int lc = 0;
#pragma unroll
    for (int j = 0; j < 16; ++j)
        if (j < jmax) {
#pragma unroll
            for (int c = 0; c < 4; ++c) lc += (key[j][c] >= cand) ? 1 : 0;
        }
    return wave_sum_i32(lc);
}
__device__ __forceinline__ void wave_thresh256_big(const unsigned (&key)[16][4], const int jmax, const int nv, const unsigned hint, unsigned& tg) {
    unsigned est = hint;
    if (est == 0u) {
        int lm_ = 0;
#pragma unroll
        for (int j = 0; j < 16; j += 2) lm_ += (j < jmax && key[j][0] != 0u) ? 1 : 0;
        const int m = wave_sum_i32(lm_);
        int r = (256 * m + (nv >> 1)) / nv; r = r < 1 ? 1 : (r > m ? m : r);
        unsigned prefix = 0u;
        for (int bit = 31; bit >= 18; --bit) {
            const unsigned cand = prefix | (1u << bit);
            int lc = 0;
#pragma unroll
            for (int j = 0; j < 16; j += 2) lc += (j < jmax && key[j][0] >= cand) ? 1 : 0;
            if (wave_sum_i32(lc) >= r) prefix = cand;
        }
        est = prefix | (1u << 17);
    }
    const unsigned DEL = 1u << 21;
    u64 lo = est > DEL ? (u64)(est - DEL) : 0ull, hi = (u64)est + DEL;
    if (hi > 0x100000000ull) hi = 0x100000000ull;
    if (lo > 0ull) {
        const int cl = wave_count_ge16(key, jmax, (unsigned)lo);
        if (cl == 256) { tg = (unsigned)lo - 1u; return; }
        if (cl < 256) { hi = lo; lo = 0ull; }
    }
    if (hi < 0x100000000ull && hi > lo + 0ull && !(lo == 0ull && hi <= (u64)(est > DEL ? est - DEL : 0u))) {
        const int ch = wave_count_ge16(key, jmax, (unsigned)hi);
        if (ch == 256) { tg = (unsigned)hi - 1u; return; }
        if (ch > 256) { lo = hi; hi = 0x100000000ull; }
    }
    while (hi - lo > 1ull) {
        const u64 mid = lo + ((hi - lo) >> 1);
        const int c = wave_count_ge16(key, jmax, (unsigned)mid);
        if (c == 256) { tg = (unsigned)mid - 1u; return; }
        if (c > 256) lo = mid; else hi = mid;
    }
    tg = (unsigned)lo;
}
template <int NJ, int MODE, bool IDARR>
__device__ __forceinline__ int wave_compact(const unsigned (&key)[NJ][4], const unsigned short (&eidarr)[2][4], const int ebase, const int jmax, const unsigned tg, const bool take_all,
                                            unsigned short* osel, unsigned* okey, unsigned short* oidx, const int lane) {
#define EID(j, c) (IDARR ? eidarr[(j) & 1][c] : (unsigned short)(ebase + (j) * 256 + lane * 4 + (c)))
    int lg = 0, le = 0;
#pragma unroll
    for (int j = 0; j < NJ; ++j)
        if (j < jmax) {
#pragma unroll
            for (int c = 0; c < 4; ++c) { lg += (key[j][c] > tg) ? 1 : 0; le += (key[j][c] == tg) ? 1 : 0; }
        }
    int totg, tote;
    int pg = wave_excl_scan_i32(lg, totg, lane), pe = wave_excl_scan_i32(le, tote, lane);
    const int need = take_all ? 0 : 256 - totg;
#pragma unroll
    for (int j = 0; j < NJ; ++j)
        if (j < jmax) {
#pragma unroll
            for (int c = 0; c < 4; ++c) {
                const unsigned k = key[j][c];
                if (k > tg) { if (MODE == 0) osel[pg] = EID(j, c); else { okey[pg] = k; oidx[pg] = EID(j, c); } ++pg; }
                else if (k == tg && !take_all) { if (pe < need) { if (MODE == 0) osel[totg + pe] = EID(j, c); else { okey[totg + pe] = k; oidx[totg + pe] = EID(j, c); } } ++pe; }
            }
        }
    return take_all ? totg : 256;
#undef EID
}
__device__ __forceinline__ void dsa_select_wave(const Params& P, const int t, unsigned short* sel, unsigned* lkey, unsigned short* lidx, const int lane) {
    const int n = t + 1;
    for (int i = lane; i < 272; i += 64) sel[i] = 0;
    if (n <= 256) { for (int i = lane; i < n; i += 64) sel[i] = (unsigned short)i; return; }
    const _Float16* scrow = (const _Float16*)(P.ws + O_SC) + (size_t)t * S;
    const int nh = n > 4096 ? 2 : 1;
    int cnt1 = 0; unsigned tg0 = 0u;
#pragma unroll 1
    for (int h = 0; h < nh; ++h) {
        const int base = h * 4096;
        const int nv = (n - base) < 4096 ? (n - base) : 4096;
        const int jmax = (nv + 255) >> 8;
        unsigned key[16][4]; const unsigned short noid[2][4] = {{0, 0, 0, 0}, {0, 0, 0, 0}};
#pragma unroll
        for (int j = 0; j < 16; ++j) {
            if (j < jmax) {
                typedef _Float16 h4_t __attribute__((ext_vector_type(4)));
                const f32x4 v = __builtin_convertvector(*(const h4_t*)(scrow + base + j * 256 + lane * 4), f32x4);
#pragma unroll
                for (int c = 0; c < 4; ++c) key[j][c] = (base + j * 256 + lane * 4 + c <= t) ? f2key(v[c]) : 0u;
            } else {
#pragma unroll
                for (int c = 0; c < 4; ++c) key[j][c] = 0u;
            }
        }
        const bool all = nv <= 256;
        unsigned tg = 0u;
        if (!all) { wave_thresh256_big(key, jmax, nv, h == 1 ? tg0 : 0u, tg); if (h == 0) tg0 = tg; }
        if (nh == 1) wave_compact<16, 0, false>(key, noid, base, jmax, tg, false, sel, lkey, lidx, lane);
        else { const int c = wave_compact<16, 1, false>(key, noid, base, jmax, tg, all, sel, lkey + h * 256, lidx + h * 256, lane); if (h == 1) cnt1 = c; }
    }
    if (nh == 2) {
        __builtin_amdgcn_fence(__ATOMIC_SEQ_CST, "wavefront");
        __builtin_amdgcn_wave_barrier();
        const int m = 256 + cnt1;
        unsigned key[2][4]; unsigned short eid[2][4];
#pragma unroll
        for (int j = 0; j < 2; ++j)
#pragma unroll
            for (int c = 0; c < 4; ++c) { const int i = j * 256 + lane * 4 + c; key[j][c] = i < m ? lkey[i] : 0u; eid[j][c] = lidx[i]; }
        unsigned tg = 0u;
        wave_thresh256<2>(key, 2, tg);
        wave_compact<2, 0, true>(key, eid, 0, 2, tg, false, sel, lkey, lidx, lane);
    }
}

__device__ __forceinline__ void dsa_attend(const Params& P, const int t, const unsigned short* sel, bf16_t* Vc, const int lane, const float lbound) {
    char* ws = P.ws;
    const int lm = lane & 15, g = lane >> 4;
    const int n = t + 1, nsel = n < 256 ? n : 256;
    const int ngr = (nsel + 15) >> 4;
    const bf16_t* DQ = (const bf16_t*)(ws + O_DQ); const bf16_t* DK = (const bf16_t*)(ws + O_DK); const bf16_t* DV = (const bf16_t*)(ws + O_DV);
    bf16x8 qf[4];
#pragma unroll
    for (int ks = 0; ks < 4; ++ks) qf[ks] = *(const bf16x8*)(DQ + ((size_t)t * 16 + lm) * 128 + ks * 32 + g * 8);
    f32x4 o[8];
#pragma unroll
    for (int dt = 0; dt < 8; ++dt) o[dt] = (f32x4){0.f, 0.f, 0.f, 0.f};
    float lsum = 0.f;
    bf16x8 kr[2][4]; u32x4 vr[8];
#pragma unroll
    for (int hf = 0; hf < 2; ++hf) {
        const bf16_t* kp = DK + (size_t)sel[hf * 16 + lm] * 128 + g * 8;
#pragma unroll
        for (int ks = 0; ks < 4; ++ks) kr[hf][ks] = *(const bf16x8*)(kp + ks * 32);
    }
#pragma unroll
    for (int i = 0; i < 8; ++i) vr[i] = *(const u32x4*)(DV + (size_t)sel[i * 4 + g] * 128 + lm * 8);
#pragma unroll 1
    for (int c = 0; c < 8; ++c) {
        if (2 * c >= ngr) break;
        f32x4 s0 = (f32x4){0.f, 0.f, 0.f, 0.f}, s1 = s0;
#pragma unroll
        for (int ks = 0; ks < 4; ++ks) { s0 = mfma(kr[0][ks], qf[ks], s0); s1 = mfma(kr[1][ks], qf[ks], s1); }
#pragma unroll
        for (int i = 0; i < 8; ++i) *(u32x4*)(Vc + (i * 4 + g) * 136 + lm * 8) = vr[i];
        __builtin_amdgcn_fence(__ATOMIC_SEQ_CST, "wavefront");
        __builtin_amdgcn_wave_barrier();
        if (c < 7 && 2 * (c + 1) < ngr) {
#pragma unroll
            for (int hf = 0; hf < 2; ++hf) {
                const bf16_t* kp = DK + (size_t)sel[(c + 1) * 32 + hf * 16 + lm] * 128 + g * 8;
#pragma unroll
                for (int ks = 0; ks < 4; ++ks) kr[hf][ks] = *(const bf16x8*)(kp + ks * 32);
            }
#pragma unroll
            for (int i = 0; i < 8; ++i) vr[i] = *(const u32x4*)(DV + (size_t)sel[(c + 1) * 32 + i * 4 + g] * 128 + lm * 8);
        }
        float p0[4], p1[4];
#pragma unroll
        for (int r = 0; r < 4; ++r) {
            p0[r] = (c * 32 + g * 4 + r < nsel) ? __builtin_amdgcn_exp2f(s0[r] - lbound) : 0.f;
            p1[r] = (c * 32 + 16 + g * 4 + r < nsel) ? __builtin_amdgcn_exp2f(s1[r] - lbound) : 0.f;
            lsum += p0[r] + p1[r];
        }
        u32x4 t4;
        t4.x = pk_bf16(p0[0], p0[1]); t4.y = pk_bf16(p0[2], p0[3]); t4.z = pk_bf16(p1[0], p1[1]); t4.w = pk_bf16(p1[2], p1[3]);
        const bf16x8 pf = __builtin_bit_cast(bf16x8, t4);
        typedef short v4i16_t __attribute__((ext_vector_type(4)));
        const bf16_t* tb = Vc + (g * 4 + (lm >> 2)) * 136 + (lm & 3) * 4;
#pragma unroll
        for (int dt = 0; dt < 8; ++dt) {
            const v4i16_t lo = __builtin_amdgcn_ds_read_tr16_b64_v4i16((__attribute__((address_space(3))) v4i16_t*)(tb + dt * 16));
            const v4i16_t hi = __builtin_amdgcn_ds_read_tr16_b64_v4i16((__attribute__((address_space(3))) v4i16_t*)(tb + 16 * 136 + dt * 16));
            bf16x8 a;
            a[0] = lo[0]; a[1] = lo[1]; a[2] = lo[2]; a[3] = lo[3]; a[4] = hi[0]; a[5] = hi[1]; a[6] = hi[2]; a[7] = hi[3];
            o[dt] = mfma(a, pf, o[dt]);
        }
        __builtin_amdgcn_fence(__ATOMIC_SEQ_CST, "wavefront");
        __builtin_amdgcn_wave_barrier();
    }
    lsum += __shfl_xor(lsum, 16); lsum += __shfl_xor(lsum, 32);
    const float inv = 1.0f / lsum;
    bf16_t* MIX = (bf16_t*)(ws + O_MIX) + (size_t)t * D + 2048 + lm * 128;
#pragma unroll
    for (int dt = 0; dt < 8; ++dt) {
        u32x2 t2; t2.x = pk_bf16(o[dt][0] * inv, o[dt][1] * inv); t2.y = pk_bf16(o[dt][2] * inv, o[dt][3] * inv);
        *(u32x2*)(MIX + dt * 16 + g * 4) = t2;
    }
}

__device__ __forceinline__ void phase3(const Params& P, char* smem) {
    unsigned* ctr = (unsigned*)(P.ws + O_CTR);
    int* slot = (int*)(smem + 131072);
    const int w = threadIdx.x >> 6, lane = threadIdx.x & 63;
    for (;;) {
        __syncthreads();
        if (threadIdx.x == 0) *slot = (int)atomicAdd(ctr, 1u);
        __syncthreads();
        const int item = *slot;
        if (item >= 512) break;
        fox_item(P, item & 15, 31 - (item >> 4), smem);
    }
    float dsa_lbound;
    {
        float mq = fmaxf(fabsf(P.dqg[lane]), fabsf(P.dqg[lane + 64])), mk = fmaxf(fabsf(P.dkg[lane]), fabsf(P.dkg[lane + 64]));
#pragma unroll
        for (int o2 = 32; o2; o2 >>= 1) { mq = fmaxf(mq, __shfl_xor(mq, o2)); mk = fmaxf(mk, __shfl_xor(mk, o2)); }
        dsa_lbound = 128.0f * QSCALE * mq * mk * 1.01f;
    }
    for (;;) {
        __syncthreads();
        if (threadIdx.x == 0) *slot = (int)atomicAdd(ctr + 32, 1u);
        __syncthreads();
        const int item = *slot;
        if (item >= S / 8) break;
        const int t0 = S - 8 - 8 * item;
        char* wsm = smem + w * 12544;
        dsa_select_wave(P, t0 + w, (unsigned short*)wsm, (unsigned*)(wsm + 576), (unsigned short*)(wsm + 2624), lane);
        __builtin_amdgcn_fence(__ATOMIC_SEQ_CST, "wavefront");
        __builtin_amdgcn_wave_barrier();
        dsa_attend(P, t0 + w, (const unsigned short*)wsm, (bf16_t*)(wsm + 3648), lane, dsa_lbound);
    }
}

template <int NV>
__device__ __forceinline__ void wave_top16(const float (&val)[NV], const int (&idx)[NV], float* outv, int* outi, const int lane) {
    unsigned key[NV];
#pragma unroll
    for (int v = 0; v < NV; ++v) key[v] = f2key(val[v]);
    unsigned prefix = 0; bool exact = false;
    for (int bit = 31; bit >= 0; --bit) {
        const unsigned cand = prefix | (1u << bit);
        int cnt = 0;
#pragma unroll
        for (int v = 0; v < NV; ++v) cnt += popc(ballot(key[v] >= cand));
        if (cnt >= 16) { prefix = cand; if (cnt == 16) { exact = true; break; } }
    }
    const unsigned tg = exact ? prefix - 1u : prefix;
    int cgt = 0;
#pragma unroll
    for (int v = 0; v < NV; ++v) cgt += popc(ballot(key[v] > tg));
    const int need = 16 - cgt;
    const u64 lt = (1ull << lane) - 1ull;
    int base = 0, tbase = 0;
#pragma unroll
    for (int v = 0; v < NV; ++v) {
        const bool gt = key[v] > tg; const u64 mg = ballot(gt);
        if (gt) { const int p = base + popc(mg & lt); outv[p] = val[v]; outi[p] = idx[v]; }
        base += popc(mg);
        const bool eq = key[v] == tg; const u64 me = ballot(eq);
        const int tp = tbase + popc(me & lt);
        if (eq && tp < need) { outv[cgt + tp] = val[v]; outi[cgt + tp] = idx[v]; }
        tbase += popc(me);
    }
}

__device__ __forceinline__ void peer_token(const Params& P, const int t, char* wsm, const int lane) {
    char* ws = P.ws;
    int* eidx = (int*)wsm;
    float* gate = (float*)(wsm + 512);
    float* aval = (float*)(wsm + 1024);
    float* l1v = (float*)(wsm + 1536); int* l1i = (int*)(wsm + 1600);
    float* l2v = (float*)(wsm + 1664); int* l2i = (int*)(wsm + 1728);
    float* bv = (float*)(wsm + 1792); int* bi = (int*)(wsm + 1856);
    const bf16_t* QP = (const bf16_t*)(ws + O_QP) + (size_t)t * 1024;
    const bf16_t* K1 = (const bf16_t*)(ws + O_K1); const bf16_t* K2 = (const bf16_t*)(ws + O_K2);
    const float rstd = rsqrtf(wave_sum(((const float*)(ws + O_PART))[(size_t)t * 64 + lane]) * (1.0f / 4096.0f) + 1e-6f);
    for (int hh = 0; hh < 8; ++hh) {
        float s1[2] = {0.f, 0.f}, s2[2] = {0.f, 0.f};
        const u32x4* q1 = (const u32x4*)(QP + hh * 128); const u32x4* q2 = (const u32x4*)(QP + hh * 128 + 64);
        const u32x4* ka = (const u32x4*)(K1 + (size_t)hh * 8192) + lane; const u32x4* kc = (const u32x4*)(K2 + (size_t)hh * 8192) + lane;
#pragma unroll
        for (int c = 0; c < 8; ++c) {
            const u32x4 x1 = q1[c], x2 = q2[c], a = ka[c * 128], b = ka[c * 128 + 64], cc = kc[c * 128], d = kc[c * 128 + 64];
#pragma unroll
            for (int q = 0; q < 4; ++q) { s1[0] = fdot2(x1[q], a[q], s1[0]); s1[1] = fdot2(x1[q], b[q], s1[1]); s2[0] = fdot2(x2[q], cc[q], s2[0]); s2[1] = fdot2(x2[q], d[q], s2[1]); }
        }
        const int id2[2] = {lane, lane + 64};
        wave_top16<2>(s1, id2, l1v, l1i, lane);
        wave_top16<2>(s2, id2, l2v, l2i, lane);
        __builtin_amdgcn_fence(__ATOMIC_SEQ_CST, "wavefront");
        __builtin_amdgcn_wave_barrier();
        float cv[4]; int ci[4];
#pragma unroll
        for (int c = 0; c < 4; ++c) { ci[c] = c * 64 + lane; cv[c] = l1v[ci[c] >> 4] + l2v[ci[c] & 15]; }
        wave_top16<4>(cv, ci, bv, bi, lane);
        __builtin_amdgcn_fence(__ATOMIC_SEQ_CST, "wavefront");
        __builtin_amdgcn_wave_barrier();
        float m = NEG_INF;
#pragma unroll
        for (int k = 0; k < 16; ++k) m = fmaxf(m, bv[k]);
        float sum = 0.f;
#pragma unroll
        for (int k = 0; k < 16; ++k) sum += expf((bv[k] - m) * rstd);
        if (lane < 16) {
            const int c = bi[lane];
            eidx[hh * 16 + lane] = l1i[c >> 4] * 128 + l2i[c & 15];
            gate[hh * 16 + lane] = expf((bv[lane] - m) * rstd) / sum;
        }
        __builtin_amdgcn_fence(__ATOMIC_SEQ_CST, "wavefront");
        __builtin_amdgcn_wave_barrier();
    }
    {
        int* seidx = (int*)(wsm + 2048); float* sgate = (float*)(wsm + 2560);
        const int e0 = eidx[lane], e1 = eidx[lane + 64]; const float g0 = gate[lane], g1 = gate[lane + 64];
        int r0 = 0, r1 = 0;
#pragma unroll 8
        for (int k = 0; k < 128; ++k) {
            const int ek = eidx[k];
            r0 += (ek < e0 || (ek == e0 && k < lane)) ? 1 : 0;
            r1 += (ek < e1 || (ek == e1 && k < lane + 64)) ? 1 : 0;
        }
        seidx[r0] = e0; sgate[r0] = g0; seidx[r1] = e1; sgate[r1] = g1;
        __builtin_amdgcn_fence(__ATOMIC_SEQ_CST, "wavefront");
        __builtin_amdgcn_wave_barrier();
        eidx = seidx; gate = sgate;
    }
    float xf[64];
    {
        const bf16_t* xrow = (const bf16_t*)(ws + O_H2) + (size_t)t * D;
#pragma unroll
        for (int h = 0; h < 2; ++h)
#pragma unroll
            for (int q = 0; q < 8; ++q) {
                const u32x2 a = ((const u32x2*)(xrow + h * 2048 + q * 256))[lane];
                xf[h * 32 + 4 * q] = bf_lo(a.x); xf[h * 32 + 4 * q + 1] = bf_hi(a.x); xf[h * 32 + 4 * q + 2] = bf_lo(a.y); xf[h * 32 + 4 * q + 3] = bf_hi(a.y);
            }
    }
    const unsigned char* UB = (const unsigned char*)(ws + O_UB); const unsigned char* VB = (const unsigned char*)(ws + O_VB);
    {
        u32x4 rr[2][3];
#pragma unroll
        for (int j = 0; j < 2; ++j) {
            const int e = __builtin_amdgcn_readfirstlane(eidx[j]);
            const u32x4* rp = (const u32x4*)(UB + (size_t)e * 3072) + lane;
#pragma unroll
            for (int c = 0; c < 3; ++c) rr[j][c] = rp[c * 64];
        }
        for (int k = 0; k < 128; k += 2) {
            float dsum[2];
#pragma unroll
            for (int j = 0; j < 2; ++j) {
                const v32f_t wa = __builtin_amdgcn_cvt_scalef32_pk32_f32_fp6((v6u_t){rr[j][0][0], rr[j][0][1], rr[j][0][2], rr[j][0][3], rr[j][1][0], rr[j][1][1]}, 1.0f);
                const v32f_t wb = __builtin_amdgcn_cvt_scalef32_pk32_f32_fp6((v6u_t){rr[j][1][2], rr[j][1][3], rr[j][2][0], rr[j][2][1], rr[j][2][2], rr[j][2][3]}, 1.0f);
                float d0 = 0.f, d1 = 0.f;
#pragma unroll
                for (int i = 0; i < 32; ++i) { d0 += wa[i] * xf[i]; d1 += wb[i] * xf[32 + i]; }
                dsum[j] = d0 + d1;
            }
            if (k + 2 < 128) {
#pragma unroll
                for (int j = 0; j < 2; ++j) {
                    const int e = __builtin_amdgcn_readfirstlane(eidx[k + 2 + j]);
                    const u32x4* rp = (const u32x4*)(UB + (size_t)e * 3072) + lane;
#pragma unroll
                    for (int c = 0; c < 3; ++c) rr[j][c] = rp[c * 64];
                }
            }
#pragma unroll
            for (int j = 0; j < 2; ++j) dsum[j] = wave_sum(dsum[j]);
            if (lane == 0) {
#pragma unroll
                for (int j = 0; j < 2; ++j) {
                    const float hv = dsum[j] * (rstd * (1.0f / U_SCALE));
                    aval[k + j] = gate[k + j] * 0.5f * hv * (1.0f + erff(hv * 0.70710678118654752f)) * (1.0f / V_SCALE);
                }
            }
        }
    }
    __builtin_amdgcn_fence(__ATOMIC_SEQ_CST, "wavefront");
    __builtin_amdgcn_wave_barrier();
    float acc[64];
#pragma unroll
    for (int i = 0; i < 64; ++i) acc[i] = 0.f;
    for (int k = 0; k < 128; k += 2) {
        u32x4 rr[2][3];
#pragma unroll
        for (int j = 0; j < 2; ++j) {
            const int e = __builtin_amdgcn_readfirstlane(eidx[k + j]);
            const u32x4* rp = (const u32x4*)(VB + (size_t)e * 3072) + lane;
#pragma unroll
            for (int c = 0; c < 3; ++c) rr[j][c] = rp[c * 64];
        }
#pragma unroll
        for (int j = 0; j < 2; ++j) {
            const float av = aval[k + j];
            const v32f_t wa = __builtin_amdgcn_cvt_scalef32_pk32_f32_fp6((v6u_t){rr[j][0][0], rr[j][0][1], rr[j][0][2], rr[j][0][3], rr[j][1][0], rr[j][1][1]}, 1.0f);
            const v32f_t wb = __builtin_amdgcn_cvt_scalef32_pk32_f32_fp6((v6u_t){rr[j][1][2], rr[j][1][3], rr[j][2][0], rr[j][2][1], rr[j][2][2], rr[j][2][3]}, 1.0f);
#pragma unroll
            for (int i = 0; i < 32; ++i) { acc[i] += av * wa[i]; acc[32 + i] += av * wb[i]; }
        }
    }
    float* orow = P.out + (size_t)t * D;
#pragma unroll
    for (int h = 0; h < 2; ++h)
#pragma unroll
        for (int q = 0; q < 8; ++q) {
            f32x4* p4 = (f32x4*)(orow + h * 2048 + q * 256) + lane;
            f32x4 xv = *p4;
            xv[0] += acc[h * 32 + 4 * q]; xv[1] += acc[h * 32 + 4 * q + 1]; xv[2] += acc[h * 32 + 4 * q + 2]; xv[3] += acc[h * 32 + 4 * q + 3];
            *p4 = xv;
        }
}

__device__ __forceinline__ void phase7(const Params& P, char* smem) {
    const int w = threadIdx.x >> 6, lane = threadIdx.x & 63;
    const int nw = gridDim.x * NWV;
    for (int t = blockIdx.x * NWV + w; t < S; t += nw) peer_token(P, t, smem + w * 4096, lane);
}

#define LAS __attribute__((address_space(3)))
#define XB_TMO      128
#define XB_XCNT(j)  (256  + 64 * (j))
#define XB_XSUB(j)  (1280 + 64 * (j))
#define XB_XGEN(j)  (2304 + 64 * (j))
#define XB_TOP      3328
#define XB_TOPGEN   3392
#define XCD_BAR_WORDS 3456
#define XB_SPIN_CAP (1u << 18)

__device__ __forceinline__ unsigned xb_ld(unsigned* p)              { return __hip_atomic_load(p, __ATOMIC_RELAXED, __HIP_MEMORY_SCOPE_AGENT); }
__device__ __forceinline__ unsigned xb_add(unsigned* p, unsigned v) { return __hip_atomic_fetch_add(p, v, __ATOMIC_RELAXED, __HIP_MEMORY_SCOPE_AGENT); }
__device__ __forceinline__ unsigned xb_xcc_id() { return (unsigned)__builtin_amdgcn_s_getreg((3 << 11) | 20) & 0xFu; }
#define XB_SPIN(cond, bar) do { unsigned _sp = 0; while (cond) { __builtin_amdgcn_s_sleep(1); \
    if ((++_sp & 255u) == 0u) { if (xb_ld(&(bar)[XB_TMO])) break; if (_sp > XB_SPIN_CAP) { atomicAdd(&(bar)[XB_TMO], 1u); break; } } } } while (0)

struct XcdBarrier {
    unsigned* bar; unsigned x;
    volatile LAS unsigned* st;
};

__device__ __forceinline__ XcdBarrier xcd_barrier_post(unsigned* bar, volatile LAS unsigned* st) {
    XcdBarrier b; b.bar = bar; b.x = xb_xcc_id(); b.st = st;
    if (threadIdx.x == 0) (void)xb_add(&bar[XB_XCNT(b.x)], 1u);
    return b;
}
__device__ __forceinline__ void xcd_barrier_complete(unsigned* bar, unsigned x, unsigned& nloc, unsigned& nx) {
    const unsigned G = gridDim.x * gridDim.y * gridDim.z;
    unsigned sum, cnt, mine, sp = 0u;
    for (;;) {
        sum = 0u; cnt = 0u; mine = 0u;
#pragma unroll
        for (unsigned j = 0; j < 16; ++j) { const unsigned c = xb_ld(&bar[XB_XCNT(j)]); sum += c; cnt += (c > 0u) ? 1u : 0u; mine = (j == x) ? c : mine; }
        if (sum == G) break;
        __builtin_amdgcn_s_sleep(1);
        if ((++sp & 255u) == 0u) { if (xb_ld(&bar[XB_TMO])) break; if (sp > XB_SPIN_CAP) { atomicAdd(&bar[XB_TMO], 1u); break; } }
    }
    nloc = mine > 0u ? mine : 1u; nx = cnt > 0u ? cnt : 1u;
}

__device__ __forceinline__ void xcd_barrier(const XcdBarrier& b) {
    asm volatile("s_waitcnt vmcnt(0)" ::: "memory");
    __syncthreads();
    if (threadIdx.x == 0) {
        unsigned* bar = b.bar;
        __builtin_amdgcn_s_waitcnt(0);
        unsigned nloc = b.st[0], nx = b.st[1];
        if (nloc == 0u) { xcd_barrier_complete(bar, b.x, nloc, nx); b.st[0] = nloc; b.st[1] = nx; }
        const unsigned old = xb_add(&bar[XB_XSUB(b.x)], 1u);
        const unsigned gen = old / nloc;
        if (old + 1u == (gen + 1u) * nloc) {
            __builtin_amdgcn_fence(__ATOMIC_RELEASE, "agent");
            asm volatile("s_waitcnt vmcnt(0)" ::: "memory");
            const unsigned og = xb_add(&bar[XB_TOP], 1u);
            const unsigned tg = og / nx;
            if (og + 1u == (tg + 1u) * nx) xb_add(&bar[XB_TOPGEN], 1u);
            else XB_SPIN(xb_ld(&bar[XB_TOPGEN]) == tg, bar);
            __builtin_amdgcn_fence(__ATOMIC_ACQUIRE, "agent");
            xb_add(&bar[XB_XGEN(b.x)], 1u);
            asm volatile("s_waitcnt vmcnt(0)" ::: "memory");
        } else {
            XB_SPIN(xb_ld(&bar[XB_XGEN(b.x)]) == gen, bar);
            __builtin_amdgcn_fence(__ATOMIC_ACQUIRE, "agent");
            asm volatile("s_waitcnt vmcnt(0)" ::: "memory");
        }
    }
    __syncthreads();
}

constexpr int LDS_BYTES = 147456;
__global__ void __launch_bounds__(NT, 2) mega(Params P) {
    extern __shared__ __attribute__((aligned(16))) char smem[];
    cg::grid_group grid = cg::this_grid();
    volatile LAS unsigned* xst = (volatile LAS unsigned*)(smem + 131072 + 64);
    if (threadIdx.x == 0) { xst[0] = 0u; xst[1] = 0u; }
    const XcdBarrier xb = xcd_barrier_post((unsigned*)(P.ws + O_XB), xst);
    phase0(P, smem);
    if (P.ws == nullptr) grid.sync();
    xcd_barrier(xb);
    gemm_phase<0>(P, smem);
    xcd_barrier(xb);
    post_phase(P);
    xcd_barrier(xb);
    phase2(P, smem);
    xcd_barrier(xb);
    phase3(P, smem);
    xcd_barrier(xb);
    gemm_phase<1>(P, smem);
    xcd_barrier(xb);
    gemm_phase<2>(P, smem);
    xcd_barrier(xb);
    phase7(P, smem);
}

extern "C" void kernel_launch(void* const* d_in, const int* in_sizes, int n_in, void* d_out, int out_size, void* d_ws, size_t ws_size, hipStream_t stream) {
    (void)in_sizes; (void)n_in; (void)out_size;
    if (ws_size < WS_TOTAL2) { fprintf(stderr, "workspace too small: %zu < %zu\n", ws_size, (size_t)WS_TOTAL2); return; }
    Params P{};
    P.x = (const float*)d_in[0]; P.pos = (const int*)d_in[1]; P.ln1 = (const float*)d_in[2]; P.w_in = (const float*)d_in[3];
    P.fb = (const float*)d_in[4]; P.fqg = (const float*)d_in[5]; P.fkg = (const float*)d_in[6]; P.dqg = (const float*)d_in[7];
    P.dkg = (const float*)d_in[8]; P.w_o = (const float*)d_in[9]; P.ln2 = (const float*)d_in[10]; P.wq = (const float*)d_in[11];
    P.k1 = (const float*)d_in[12]; P.k2 = (const float*)d_in[13]; P.u = (const float*)d_in[14]; P.v = (const float*)d_in[15];
    P.out = (float*)d_out; P.ws = (char*)d_ws;
    static int grid_blocks = 0;
    if (!grid_blocks) {
        int dev = 0, cus = 0, per_cu = 0;
        (void)hipGetDevice(&dev);
        (void)hipDeviceGetAttribute(&cus, hipDeviceAttributeMultiprocessorCount, dev);
        if (hipFuncSetAttribute((const void*)mega, hipFuncAttributeMaxDynamicSharedMemorySize, LDS_BYTES) != hipSuccess) fprintf(stderr, "hipFuncSetAttribute failed\n");
        (void)hipOccupancyMaxActiveBlocksPerMultiprocessor(&per_cu, (const void*)mega, NT, LDS_BYTES);
        if (per_cu != 1) fprintf(stderr, "note: occupancy query reports %d workgroups per CU\n", per_cu);
        grid_blocks = cus;
    }
    (void)hipMemsetAsync((char*)d_ws + O_CTR, 0, 256 + 3456 * 4, stream);
    void* args[] = {&P};
    hipError_t e = hipLaunchCooperativeKernel((void*)mega, dim3(grid_blocks), dim3(NT), args, LDS_BYTES, stream);
    if (e != hipSuccess) fprintf(stderr, "cooperative launch failed: %s (grid %d)\n", hipGetErrorString(e), grid_blocks);
}
```
